# Optimizing an MI355X kernel written in HIP

```python
import math
import jax, jax.numpy as jnp
from jax import lax
import numpy as np

D_MODEL = 1024
BATCH = 8
SEQ = 2048
DEPTH = 2
DEC_BATCH = 128
DEC_SEQ = 4
PAST_LEN = 16384
PAGE_SIZE = 128

RW_HEADS = 4
RW_DIM = 64
RW_WIDTH = RW_HEADS * RW_DIM
RW_DECAY_LORA = 64
RW_AAA_LORA = 64
RW_GATE_LORA = 128
RW_PROJ = 3 * RW_WIDTH + RW_DECAY_LORA + RW_AAA_LORA + RW_GATE_LORA
RW_SPLITS = [RW_WIDTH, 2 * RW_WIDTH, 3 * RW_WIDTH, 3 * RW_WIDTH + RW_DECAY_LORA,
             3 * RW_WIDTH + RW_DECAY_LORA + RW_AAA_LORA]
RW_GN_EPS = 64e-5
HG_HEADS = 4
HG_DIM = 128
HG_WIDTH = HG_HEADS * HG_DIM
HG_PROJ = 4 * HG_WIDTH
HG_CHUNK = 16
RMS_EPS = 1e-6
F_MIN = 1e-30
CM_HEADS = 4
CM_DIM = 64
CM_WIDTH = CM_HEADS * CM_DIM
CM_CHUNK = 128
CM_PROJ = 2 * CM_WIDTH
MIX_WIDTH = RW_WIDTH + HG_WIDTH + CM_WIDTH
IN_PROJ = RW_PROJ + HG_PROJ + CM_PROJ
D_FF = 2816
LN_EPS = 1e-5
ALPHA = (2.0 * DEPTH) ** 0.25
BETA = (8.0 * DEPTH) ** -0.25

kernel_name = "hybrid_rwkv7_hgrn2_chunkgmlp_decoder_step"


def layer_norm(x, g, b, eps=LN_EPS):
    xf = x.astype(jnp.float32)
    mu = xf.mean(-1, keepdims=True)
    var = jnp.square(xf - mu).mean(-1, keepdims=True)
    return ((xf - mu) * lax.rsqrt(var + eps) * g + b).astype(x.dtype)


def swiglu(x, w_in, w_out):
    gate, up = jnp.split(x @ w_in, 2, axis=-1)
    return (jax.nn.silu(gate) * up) @ w_out


def rwkv7_mix(z, shift0, S0, mu, w0, w_w2, a0, a_w2, g_w2, k_k, k_a, r_k, gn_g, gn_b):
    B, T, _ = z.shape
    f32 = jnp.float32
    z_prev = jnp.concatenate([shift0[:, None, :].astype(z.dtype), z[:, :-1]], axis=1)
    zs = (z + (z_prev - z) * mu).astype(f32)
    r, k, v, xw, xa, xg = jnp.split(zs, RW_SPLITS, axis=-1)
    w_log = -jax.nn.softplus(-(w0 + jnp.tanh(xw) @ w_w2)) - 0.5
    decay = jnp.exp(-jnp.exp(w_log))
    a = jax.nn.sigmoid(a0 + xa @ a_w2)
    g = jax.nn.sigmoid(xg) @ g_w2
    kk = k * k_k
    k = k * (1.0 + (a - 1.0) * k_a)
    hs = lambda t: t.reshape(B, T, RW_HEADS, RW_DIM)
    r, decay, k, v, kk, a = map(hs, (r, decay, k, v, kk, a))
    kk = kk / jnp.maximum(jnp.sqrt(jnp.sum(kk * kk, axis=-1, keepdims=True)), 1e-12)

    def step(S, inp):
        r_t, w_t, k_t, v_t, kk_t, a_t = inp
        sa = jnp.einsum('bhvk,bhk->bhv', S, -kk_t)
        S = (S * w_t[:, :, None, :] + sa[..., None] * (kk_t * a_t)[:, :, None, :]
             + v_t[..., None] * k_t[:, :, None, :])
        return S, jnp.einsum('bhvk,bhk->bhv', S, r_t)

    tm = lambda t: jnp.moveaxis(t, 1, 0)
    S_T, o = lax.scan(step, S0.astype(f32), tuple(map(tm, (r, decay, k, v, kk, a))))
    o = jnp.moveaxis(o, 0, 1)
    o_mu = o.mean(-1, keepdims=True)
    o_var = jnp.square(o - o_mu).mean(-1, keepdims=True)
    o = ((o - o_mu) * lax.rsqrt(o_var + RW_GN_EPS)).reshape(B, T, RW_WIDTH) * gn_g + gn_b
    o = o + (jnp.sum(r * k * r_k, axis=-1, keepdims=True) * v).reshape(B, T, RW_WIDTH)
    o = o * g
    return o.astype(z.dtype), S_T.astype(S0.dtype), z[:, -1]


def gated_linear_recurrence(q, k, v, log_f, S0):
    B, T, H, K = q.shape
    C = math.gcd(T, HG_CHUNK)
    N = T // C
    mask = jnp.tril(jnp.ones((C, C), dtype=bool))[None, :, :, None, None]
    to_chunks = lambda t: jnp.moveaxis(t.reshape(B, N, C, H, t.shape[-1]), 1, 0)

    def step(S, inp):
        qc, kc, vc, gc = inp
        cum = jnp.cumsum(gc, axis=1)
        diff = cum[:, :, None] - cum[:, None, :]
        dec = jnp.where(mask, jnp.exp(jnp.minimum(diff, 0.0)), 0.0)
        A = jnp.einsum('bthk,bshk,btshk->bhts', qc, kc, dec)
        o = (jnp.einsum('bhts,bshv->bthv', A, vc)
             + jnp.einsum('bthk,bhkv->bthv', qc * jnp.exp(cum), S))
        total = cum[:, -1]
        S = (jnp.exp(total)[..., None] * S
             + jnp.einsum('bshk,bshv->bhkv', kc * jnp.exp(total[:, None] - cum), vc))
        return S, o

    S_T, o = lax.scan(step, S0, (to_chunks(q), to_chunks(k), to_chunks(v), to_chunks(log_f)))
    return jnp.moveaxis(o, 0, 1).reshape(B, T, H, v.shape[-1]), S_T


def hgrn2_mix(z, S0, lb, norm_g):
    B, T, _ = z.shape
    f32 = jnp.float32
    q, fz, i, og = jnp.split(z.astype(f32), 4, axis=-1)
    lbf = lb.astype(f32)
    f = lbf + (1.0 - lbf) * jax.nn.sigmoid(fz)
    log_f = jnp.log(jnp.maximum(f, F_MIN))
    k = 1.0 - f
    hs = lambda t: t.reshape(B, T, HG_HEADS, HG_DIM)
    o, S_T = gated_linear_recurrence(hs(jax.nn.silu(q)), hs(k), hs(i), hs(log_f), S0.astype(f32))
    o = o * lax.rsqrt(jnp.mean(o * o, axis=-1, keepdims=True) + RMS_EPS)
    o = o.reshape(B, T, HG_WIDTH) * norm_g * jax.nn.silu(og)
    return o.astype(z.dtype), S_T.astype(S0.dtype)


def chunk_mlp_mix(z, ws, bs, ln_g, ln_b):
    B, T, _ = z.shape
    u, v = jnp.split(z, 2, axis=-1)
    u = jax.nn.gelu(u, approximate=False)
    v = jax.nn.gelu(v, approximate=False).reshape(B, T, CM_HEADS, CM_DIM)
    v = layer_norm(v, ln_g.reshape(CM_HEADS, CM_DIM), ln_b.reshape(CM_HEADS, CM_DIM))
    Tp = -(-T // CM_CHUNK) * CM_CHUNK
    vp = jnp.pad(v, ((0, 0), (0, Tp - T), (0, 0), (0, 0))).reshape(B, Tp // CM_CHUNK, CM_CHUNK, CM_HEADS, CM_DIM)
    w_causal = ws * jnp.tril(jnp.ones((CM_CHUNK, CM_CHUNK), ws.dtype))
    mixed = jnp.einsum('hts,bnshd->bnthd', w_causal, vp) + bs.T[None, None, :, :, None]
    mixed = mixed.reshape(B, Tp, CM_HEADS, CM_DIM)[:, :T].reshape(B, T, CM_WIDTH)
    return u * mixed, v.reshape(B, T, CM_WIDTH)


def hgrn_lower_bounds(logits):
    s = jax.nn.softmax(logits.astype(jnp.float32), axis=0)
    return jnp.cumsum(s, axis=0) - s[0]


def run_trunk(x, rw_S0, rw_shift0, hg_S0, p):
    lb = hgrn_lower_bounds(p['hg_lb_logits'])
    rw_S, rw_sh, hg_S, cm_v = [], [], [], []
    for l in range(DEPTH):
        x = layer_norm(ALPHA * x + 0.5 * swiglu(x, p['ffn1_w_in'][l], p['ffn1_w_out'][l]),
                       p['ln1_g'][l], p['ln1_b'][l])
        z = x @ p['mix_w_in'][l]
        z_rw, z_hg, z_cm = jnp.split(z, [RW_PROJ, RW_PROJ + HG_PROJ], axis=-1)
        o_rw, s_rw, sh_rw = rwkv7_mix(z_rw, rw_shift0[l], rw_S0[l], p['rw_mu'][l], p['rw_w0'][l],
                                      p['rw_w_w2'][l], p['rw_a0'][l], p['rw_a_w2'][l], p['rw_g_w2'][l],
                                      p['rw_k_k'][l], p['rw_k_a'][l], p['rw_r_k'][l],
                                      p['rw_gn_g'][l], p['rw_gn_b'][l])
        o_hg, s_hg = hgrn2_mix(z_hg, hg_S0[l], lb[l], p['hg_norm_g'][l])
        o_cm, v_cm = chunk_mlp_mix(z_cm, p['cm_ws'][l], p['cm_bs'][l], p['cm_ln_g'][l], p['cm_ln_b'][l])
        mix = jnp.concatenate([o_rw, o_hg, o_cm], axis=-1) @ p['mix_w_out'][l]
        x = layer_norm(ALPHA * x + mix, p['ln2_g'][l], p['ln2_b'][l])
        x = layer_norm(ALPHA * x + 0.5 * swiglu(x, p['ffn2_w_in'][l], p['ffn2_w_out'][l]),
                       p['ln3_g'][l], p['ln3_b'][l])
        rw_S.append(s_rw)
        rw_sh.append(sh_rw)
        hg_S.append(s_hg)
        cm_v.append(v_cm)
    return x, jnp.stack(rw_S), jnp.stack(rw_sh), jnp.stack(hg_S), jnp.stack(cm_v)


def setup_inputs(seed: int = 0) -> dict:
    key = jax.random.key(seed)
    ks = iter(jax.random.split(key, 48))
    nrm = lambda shape, s: jax.random.normal(next(ks), shape, jnp.float32) * s
    L = DEPTH
    d = {}
    d['x_prompt'] = nrm((BATCH, SEQ, D_MODEL), 1.0)
    d['x_sample'] = nrm((DEC_BATCH, DEC_SEQ, D_MODEL), 1.0)
    d['state_rwkv'] = nrm((L, DEC_BATCH, RW_HEADS, RW_DIM, RW_DIM), 0.3)
    d['state_rwkv_shift'] = nrm((L, DEC_BATCH, RW_PROJ), 1.0)
    d['state_hgrn'] = nrm((L, DEC_BATCH, HG_HEADS, HG_DIM, HG_DIM), 0.5)
    d['ffn1_w_in'] = nrm((L, D_MODEL, 2 * D_FF), D_MODEL ** -0.5)
    d['ffn1_w_out'] = nrm((L, D_FF, D_MODEL), BETA * D_FF ** -0.5)
    d['ln1_g'] = 1.0 + nrm((L, D_MODEL), 0.02)
    d['ln1_b'] = nrm((L, D_MODEL), 0.02)
    d['mix_w_in'] = nrm((L, D_MODEL, IN_PROJ), D_MODEL ** -0.5)
    d['mix_w_out'] = nrm((L, MIX_WIDTH, D_MODEL), BETA * MIX_WIDTH ** -0.5)
    d['ln2_g'] = 1.0 + nrm((L, D_MODEL), 0.02)
    d['ln2_b'] = nrm((L, D_MODEL), 0.02)
    d['rw_mu'] = jax.random.uniform(next(ks), (L, RW_PROJ), jnp.float32)
    d['rw_w0'] = -1.0 + nrm((L, RW_WIDTH), 0.5)
    d['rw_w_w2'] = nrm((L, RW_DECAY_LORA, RW_WIDTH), 0.1 * RW_DECAY_LORA ** -0.5)
    d['rw_a0'] = nrm((L, RW_WIDTH), 0.1)
    d['rw_a_w2'] = nrm((L, RW_AAA_LORA, RW_WIDTH), 0.1 * RW_AAA_LORA ** -0.5)
    d['rw_g_w2'] = nrm((L, RW_GATE_LORA, RW_WIDTH), RW_GATE_LORA ** -0.5)
    d['rw_k_k'] = 0.85 + nrm((L, RW_WIDTH), 0.02)
    d['rw_k_a'] = 1.0 + nrm((L, RW_WIDTH), 0.02)
    d['rw_r_k'] = nrm((L, RW_HEADS, RW_DIM), 0.1)
    d['rw_gn_g'] = 1.0 + nrm((L, RW_WIDTH), 0.02)
    d['rw_gn_b'] = nrm((L, RW_WIDTH), 0.02)
    d['hg_lb_logits'] = nrm((L, HG_WIDTH), 0.5)
    d['hg_norm_g'] = 1.0 + nrm((L, HG_WIDTH), 0.02)
    d['cm_ws'] = nrm((L, CM_HEADS, CM_CHUNK, CM_CHUNK), CM_CHUNK ** -0.5)
    d['cm_bs'] = 1.0 + nrm((L, CM_HEADS, CM_CHUNK), 0.1)
    d['cm_ln_g'] = 1.0 + nrm((L, CM_WIDTH), 0.02)
    d['cm_ln_b'] = nrm((L, CM_WIDTH), 0.02)
    d['ffn2_w_in'] = nrm((L, D_MODEL, 2 * D_FF), D_MODEL ** -0.5)
    d['ffn2_w_out'] = nrm((L, D_FF, D_MODEL), BETA * D_FF ** -0.5)
    d['ln3_g'] = 1.0 + nrm((L, D_MODEL), 0.02)
    d['ln3_b'] = nrm((L, D_MODEL), 0.02)
    return d


def reference(x_prompt, x_sample, state_rwkv, state_rwkv_shift, state_hgrn,
              ffn1_w_in, ffn1_w_out, ln1_g, ln1_b, mix_w_in, mix_w_out, ln2_g, ln2_b,
              rw_mu, rw_w0, rw_w_w2, rw_a0, rw_a_w2, rw_g_w2, rw_k_k, rw_k_a, rw_r_k,
              rw_gn_g, rw_gn_b, hg_lb_logits, hg_norm_g, cm_ws, cm_bs, cm_ln_g, cm_ln_b,
              ffn2_w_in, ffn2_w_out, ln3_g, ln3_b):
    p = dict(ffn1_w_in=ffn1_w_in, ffn1_w_out=ffn1_w_out, ln1_g=ln1_g, ln1_b=ln1_b,
             mix_w_in=mix_w_in, mix_w_out=mix_w_out, ln2_g=ln2_g, ln2_b=ln2_b,
             rw_mu=rw_mu, rw_w0=rw_w0, rw_w_w2=rw_w_w2, rw_a0=rw_a0, rw_a_w2=rw_a_w2,
             rw_g_w2=rw_g_w2, rw_k_k=rw_k_k, rw_k_a=rw_k_a, rw_r_k=rw_r_k,
             rw_gn_g=rw_gn_g, rw_gn_b=rw_gn_b, hg_lb_logits=hg_lb_logits, hg_norm_g=hg_norm_g,
             cm_ws=cm_ws, cm_bs=cm_bs, cm_ln_g=cm_ln_g, cm_ln_b=cm_ln_b,
             ffn2_w_in=ffn2_w_in, ffn2_w_out=ffn2_w_out, ln3_g=ln3_g, ln3_b=ln3_b)
    B = x_prompt.shape[0]
    rw_S0 = jnp.zeros((DEPTH, B, RW_HEADS, RW_DIM, RW_DIM), state_rwkv.dtype)
    rw_sh0 = jnp.zeros((DEPTH, B, RW_PROJ), state_rwkv_shift.dtype)
    hg_S0 = jnp.zeros((DEPTH, B, HG_HEADS, HG_DIM, HG_DIM), state_hgrn.dtype)
    y_prompt, rw_S_p, rw_sh_p, hg_S_p, _ = run_trunk(x_prompt, rw_S0, rw_sh0, hg_S0, p)
    y_sample, rw_S_s, rw_sh_s, hg_S_s, cm_v_s = run_trunk(x_sample, state_rwkv, state_rwkv_shift,
                                                         state_hgrn, p)
    return (y_prompt, y_sample, rw_S_p, rw_sh_p, hg_S_p, rw_S_s, rw_sh_s, hg_S_s, cm_v_s)
```

```cpp
#include <hip/hip_runtime.h>
#include <cstdio>

typedef unsigned short bf16;
typedef short bf16x8 __attribute__((ext_vector_type(8)));
typedef float f32x4 __attribute__((ext_vector_type(4)));

constexpr int D = 1024, BATCH = 8, SEQ = 2048, DEPTH = 2, DB = 128, DS = 4;
constexpr int MP = BATCH * SEQ, MS = DB * DS, M = MP + MS;
constexpr int DFF = 2816, NIN = 3584;
constexpr float ALPHA = 1.41421356237309515f;
constexpr size_t O_Y = 0, O_RWSP = 17301504, O_RWSHP = 17563648, O_HGSP = 17580032, O_RWSS = 18628608, O_RWSHS = 22822912, O_HGSS = 23085056, O_CMV = 39862272;
constexpr size_t MiB = 1u << 20;
constexpr size_t WS_W = 2 * MiB;
constexpr size_t W_1IN = 0, W_1OUT = 11 * MiB, W_MI = 17 * MiB, W_MO = 24 * MiB, W_2IN = 26 * MiB, W_2OUT = 37 * MiB, W_LAYER = 43 * MiB;
constexpr size_t WS_XB = 90 * MiB;
constexpr size_t WS_OB = 124 * MiB;
constexpr size_t WS_HZ = 158 * MiB;
constexpr size_t WS_RW = 276 * MiB;
constexpr size_t WS_RK = 392 * MiB;
constexpr size_t WS_HG = 393 * MiB;
constexpr size_t WS_RWO = 493 * MiB;
constexpr size_t WS_HGO = 510 * MiB;
constexpr size_t WS_END = 544 * MiB;

__device__ __forceinline__ bf16 f2bf(float f) { unsigned u = __float_as_uint(f); return (bf16)((u + 0x7fffu + ((u >> 16) & 1u)) >> 16); }
__device__ __forceinline__ float bf2f(bf16 b) { return __uint_as_float(((unsigned)b) << 16); }
__device__ __forceinline__ float wave_sum(float v) {
#pragma unroll
    for (int o = 1; o < 64; o <<= 1) v += __shfl_xor(v, o);
    return v;
}
__device__ __forceinline__ float sigmoidf_(float x) { return 1.0f / (1.0f + expf(-x)); }
__device__ __forceinline__ float siluf_(float x) { return x / (1.0f + expf(-x)); }
__device__ __forceinline__ float geluf_(float x) { return 0.5f * x * (1.0f + erff(x * 0.70710678118654752f)); }
__device__ __forceinline__ float softplusf_(float x) { return x > 20.0f ? x : log1pf(expf(x)); }

__global__ __launch_bounds__(256) void k_transpose_w(const float* __restrict__ W, bf16* __restrict__ WT, int K, int N, int interleave) {
    __shared__ float tile[32][33];
    const int tx = threadIdx.x & 31, ty = threadIdx.x >> 5;
    const int n0 = blockIdx.x * 32, k0 = blockIdx.y * 32;
#pragma unroll
    for (int i = 0; i < 4; ++i) tile[ty + 8 * i][tx] = W[(size_t)(k0 + ty + 8 * i) * N + n0 + tx];
    __syncthreads();
#pragma unroll
    for (int i = 0; i < 4; ++i) {
        const int n = n0 + ty + 8 * i;
        int row = n;
        if (interleave) { const int half = N / 2; const int j = n < half ? n : n - half; row = 256 * (j / 128) + (j % 128) + (n < half ? 0 : 128); }
        WT[(size_t)row * K + k0 + tx] = f2bf(tile[tx][ty + 8 * i]);
    }
}

__global__ __launch_bounds__(256) void k_cvt_x(const float* __restrict__ x, bf16* __restrict__ xb, size_t n) {
    size_t i = ((size_t)blockIdx.x * 256 + threadIdx.x) * 4;
    if (i < n) { const float4 v = *(const float4*)(x + i); ushort4 o; o.x = f2bf(v.x); o.y = f2bf(v.y); o.z = f2bf(v.z); o.w = f2bf(v.w); *(ushort4*)(xb + i) = o; }
}

template <int MODE>
__global__ __launch_bounds__(256) void k_gemm(const bf16* __restrict__ A, const bf16* __restrict__ Bt, int K, int N, bf16* outb, float* outf, float alpha, float scale) {
    __shared__ __attribute__((aligned(16))) bf16 sA[64][40];
    __shared__ __attribute__((aligned(16))) bf16 sB[MODE == 1 ? 128 : 64][40];
    const int tid = threadIdx.x, lane = tid & 63, w = tid >> 6;
    const int m0 = blockIdx.y * 64, n0 = blockIdx.x * 64;
    int brow0 = n0;
    if (MODE == 1) brow0 = 256 * (n0 / 128) + (n0 % 128);
    f32x4 acc[MODE == 1 ? 8 : 4];
#pragma unroll
    for (int i = 0; i < (MODE == 1 ? 8 : 4); ++i) acc[i] = (f32x4){0.f, 0.f, 0.f, 0.f};
    const int lr = tid >> 2, lc = (tid & 3) * 8;
    for (int k0 = 0; k0 < K; k0 += 32) {
        *(uint4*)&sA[lr][lc] = *(const uint4*)(A + (size_t)(m0 + lr) * K + k0 + lc);
        *(uint4*)&sB[lr][lc] = *(const uint4*)(Bt + (size_t)(brow0 + lr) * K + k0 + lc);
        if (MODE == 1) *(uint4*)&sB[64 + lr][lc] = *(const uint4*)(Bt + (size_t)(brow0 + 128 + lr) * K + k0 + lc);
        __syncthreads();
        const bf16x8 a = *(const bf16x8*)&sA[16 * w + (lane & 15)][8 * (lane >> 4)];
#pragma unroll
        for (int nt = 0; nt < (MODE == 1 ? 8 : 4); ++nt) {
            const bf16x8 b = *(const bf16x8*)&sB[16 * nt + (lane & 15)][8 * (lane >> 4)];
            acc[nt] = __builtin_amdgcn_mfma_f32_16x16x32_bf16(a, b, acc[nt], 0, 0, 0);
        }
        __syncthreads();
    }
#pragma unroll
    for (int nt = 0; nt < 4; ++nt)
#pragma unroll
        for (int j = 0; j < 4; ++j) {
            const int row = m0 + 16 * w + 4 * (lane >> 4) + j, col = n0 + 16 * nt + (lane & 15);
            if (MODE == 0) outb[(size_t)row * N + col] = f2bf(acc[nt][j]);
            if (MODE == 1) { const float g = acc[nt][j], u = acc[nt + 4][j]; outb[(size_t)row * DFF + col] = f2bf(siluf_(g) * u); }
            if (MODE == 2) { float* p = outf + (size_t)row * N + col; *p = alpha * (*p) + scale * acc[nt][j]; }
        }
}

__global__ __launch_bounds__(256) void k_ln(float* __restrict__ x, bf16* __restrict__ xb, const float* __restrict__ g, const float* __restrict__ b) {
    const int row = blockIdx.x * 4 + (threadIdx.x >> 6), lane = threadIdx.x & 63;
    float4* xr = (float4*)(x + (size_t)row * D) + lane;
    float4 v[4]; float s = 0.f;
#pragma unroll
    for (int j = 0; j < 4; ++j) { v[j] = xr[64 * j]; s += (v[j].x + v[j].y) + (v[j].z + v[j].w); }
    const float mean = wave_sum(s) * (1.f / D); float s2 = 0.f;
#pragma unroll
    for (int j = 0; j < 4; ++j) { v[j].x -= mean; v[j].y -= mean; v[j].z -= mean; v[j].w -= mean; s2 += (v[j].x * v[j].x + v[j].y * v[j].y) + (v[j].z * v[j].z + v[j].w * v[j].w); }
    const float rstd = rsqrtf(wave_sum(s2) * (1.f / D) + 1e-5f);
#pragma unroll
    for (int j = 0; j < 4; ++j) {
        const float4 gg = ((const float4*)g)[lane + 64 * j], bb = ((const float4*)b)[lane + 64 * j];
        float4 o; o.x = v[j].x * rstd * gg.x + bb.x; o.y = v[j].y * rstd * gg.y + bb.y; o.z = v[j].z * rstd * gg.z + bb.z; o.w = v[j].w * rstd * gg.w + bb.w;
        xr[64 * j] = o;
        ushort4 ob; ob.x = f2bf(o.x); ob.y = f2bf(o.y); ob.z = f2bf(o.z); ob.w = f2bf(o.w);
        ((ushort4*)(xb + (size_t)row * D))[lane + 64 * j] = ob;
    }
}

__device__ __forceinline__ void row_info(int m, int& b, int& t, int& T, bool& smp) {
    if (m < MP) { smp = false; b = m / SEQ; t = m % SEQ; T = SEQ; } else { smp = true; b = (m - MP) / DS; t = (m - MP) % DS; T = DS; }
}

struct RwParams { const float *mu, *w0, *w_w2, *a0, *a_w2, *g_w2, *k_k, *k_a, *r_k; };
__global__ __launch_bounds__(256) void k_rw_m1(const bf16* __restrict__ z, const float* __restrict__ shift_s  , RwParams P,
                                               float* __restrict__ ops, float* __restrict__ rk, float* __restrict__ sh_p  , float* __restrict__ sh_s  ) {
    extern __shared__ float zs[];
    const int tid = threadIdx.x, m0 = blockIdx.x * 16;
    for (int i = 0; i < 16; ++i) {
        const int m = m0 + i; int b, t, T; bool smp; row_info(m, b, t, T, smp);
#pragma unroll
        for (int q = 0; q < 4; ++q) {
            const int c = tid + 256 * q;
            const float zc = bf2f(z[(size_t)m * NIN + c]);
            float zp;
            if (t == 0) zp = smp ? shift_s[(size_t)b * 1024 + c] : 0.f; else zp = bf2f(z[(size_t)(m - 1) * NIN + c]);
            float v = zc + (zp - zc) * P.mu[c];
            if (c >= 768 && c < 832) v = tanhf(v);
            if (c >= 896) v = sigmoidf_(v);
            zs[i * 1024 + c] = v;
            if (t == T - 1) { if (smp) sh_s[(size_t)b * 1024 + c] = zc; else sh_p[(size_t)b * 1024 + c] = zc; }
        }
    }
    __syncthreads();
    const int c = tid;
    float aw[16], aa[16], ag[16];
#pragma unroll
    for (int i = 0; i < 16; ++i) { aw[i] = 0.f; aa[i] = 0.f; ag[i] = 0.f; }
    for (int j = 0; j < 64; ++j) {
        const float wv = P.w_w2[j * 256 + c], av = P.a_w2[j * 256 + c];
#pragma unroll
        for (int i = 0; i < 16; ++i) { aw[i] += zs[i * 1024 + 768 + j] * wv; aa[i] += zs[i * 1024 + 832 + j] * av; }
    }
    for (int j = 0; j < 128; ++j) {
        const float gv = P.g_w2[j * 256 + c];
#pragma unroll
        for (int i = 0; i < 16; ++i) ag[i] += zs[i * 1024 + 896 + j] * gv;
    }
    const float w0 = P.w0[c], a0 = P.a0[c], kkc = P.k_k[c], kac = P.k_a[c], rkc = P.r_k[c];
#pragma unroll
    for (int i = 0; i < 16; ++i) {
        const int m = m0 + i;
        const float r = zs[i * 1024 + c], k = zs[i * 1024 + 256 + c], v = zs[i * 1024 + 512 + c];
        const float wlog = -softplusf_(-(w0 + aw[i])) - 0.5f;
        const float decay = expf(-expf(wlog));
        const float a = sigmoidf_(a0 + aa[i]);
        float kk = k * kkc;
        const float ss = wave_sum(kk * kk);
        kk = kk / fmaxf(sqrtf(ss), 1e-12f);
        const float k2 = k * (1.0f + (a - 1.0f) * kac);
        const float rks = wave_sum(r * k2 * rkc);
        float* o = ops + (size_t)m * 1792 + c;
        o[0] = r; o[256] = decay; o[512] = k2; o[768] = v; o[1024] = kk; o[1280] = kk * a; o[1536] = ag[i];
        if ((tid & 63) == 0) rk[(size_t)m * 4 + (tid >> 6)] = rks;
    }
}

__global__ __launch_bounds__(64) void k_rw_m2(const float* __restrict__ ops, const float* __restrict__ S0  , float* __restrict__ rawo,
                                              float* __restrict__ Sp  , float* __restrict__ Ss  ) {
    const int lane = threadIdx.x; int seq = blockIdx.x >> 2; const int h = blockIdx.x & 3;
    const bool smp = seq >= BATCH; if (smp) seq -= BATCH;
    const int T = smp ? DS : SEQ; const int mbase = smp ? MP + seq * DS : seq * SEQ;
    float S[64];
    if (smp) {
#pragma unroll
        for (int k = 0; k < 64; ++k) S[k] = S0[(((size_t)seq * 4 + h) * 64 + lane) * 64 + k];
    } else {
#pragma unroll
        for (int k = 0; k < 64; ++k) S[k] = 0.f;
    }
    for (int t = 0; t < T; ++t) {
        const float* op = ops + (size_t)(mbase + t) * 1792 + h * 64;
        float sa = 0.f;
#pragma unroll
        for (int k = 0; k < 64; ++k) sa -= S[k] * op[1024 + k];
        const float vv = op[768 + lane];
        float o = 0.f;
#pragma unroll
        for (int k = 0; k < 64; ++k) { S[k] = S[k] * op[256 + k] + sa * op[1280 + k] + vv * op[512 + k]; o += S[k] * op[k]; }
        rawo[(size_t)(mbase + t) * 256 + h * 64 + lane] = o;
    }
    float* out = (smp ? Ss : Sp) + (((size_t)seq * 4 + h) * 64 + lane) * 64;
#pragma unroll
    for (int k = 0; k < 64; ++k) out[k] = S[k];
}

__global__ __launch_bounds__(256) void k_hg_m1(const bf16* __restrict__ z, const float* __restrict__ logits  , int layer, float* __restrict__ hg) {
    const int m = blockIdx.x;
    for (int c = threadIdx.x; c < 512; c += 256) {
        const bf16* zr = z + (size_t)m * NIN + 1024;
        const float q = bf2f(zr[c]), fz = bf2f(zr[512 + c]), iv = bf2f(zr[1024 + c]);
        float lb = 0.f;
        if (layer == 1) { const float l0 = logits[c], l1 = logits[512 + c]; lb = 1.0f / (1.0f + expf(l0 - l1)); }
        const float f = lb + (1.0f - lb) * sigmoidf_(fz);
        float* o = hg + (size_t)m * 1536;
        o[c] = siluf_(q); o[512 + c] = f; o[1024 + c] = iv;
    }
}
__global__ __launch_bounds__(64) void k_hg_m2(const float* __restrict__ hg, const float* __restrict__ S0  , float* __restrict__ rawo,
                                              float* __restrict__ Sp, float* __restrict__ Ss) {
    const int lane = threadIdx.x; const int vh = blockIdx.x & 1, h = (blockIdx.x >> 1) & 3; int seq = blockIdx.x >> 3;
    const bool smp = seq >= BATCH; if (smp) seq -= BATCH;
    const int T = smp ? DS : SEQ; const int mbase = smp ? MP + seq * DS : seq * SEQ;
    const int v = vh * 64 + lane;
    float S[128];
    if (smp) {
#pragma unroll
        for (int k = 0; k < 128; ++k) S[k] = S0[(((size_t)seq * 4 + h) * 128 + k) * 128 + v];
    } else {
#pragma unroll
        for (int k = 0; k < 128; ++k) S[k] = 0.f;
    }
    for (int t = 0; t < T; ++t) {
        const float* op = hg + (size_t)(mbase + t) * 1536 + h * 128;
        const float iv = op[1024 + v];
        float o = 0.f;
#pragma unroll
        for (int k = 0; k < 128; ++k) { const float f = op[512 + k]; S[k] = f * S[k] + (1.0f - f) * iv; o += op[k] * S[k]; }
        rawo[(size_t)(mbase + t) * 512 + h * 128 + v] = o;
    }
    float* out = (smp ? Ss : Sp) + ((size_t)seq * 4 + h) * 16384 + v;
#pragma unroll
    for (int k = 0; k < 128; ++k) out[(size_t)k * 128] = S[k];
}

__global__ __launch_bounds__(256) void k_m3(const bf16* __restrict__ z, const float* __restrict__ ops, const float* __restrict__ rk, const float* __restrict__ rwo, const float* __restrict__ hgo,
                                            const float* __restrict__ gn_g, const float* __restrict__ gn_b, const float* __restrict__ norm_g, bf16* __restrict__ ob) {
    const int m = blockIdx.x, tid = threadIdx.x, h = tid >> 6;
    {
        const float o = rwo[(size_t)m * 256 + tid];
        const float mean = wave_sum(o) * (1.f / 64.f); const float d = o - mean; const float var = wave_sum(d * d) * (1.f / 64.f);
        float on = d * rsqrtf(var + 64e-5f) * gn_g[tid] + gn_b[tid];
        const float* op = ops + (size_t)m * 1792;
        on += rk[(size_t)m * 4 + h] * op[768 + tid];
        on *= op[1536 + tid];
        ob[(size_t)m * D + tid] = f2bf(on);
    }
    {
        const int c = 2 * tid;
        const float o0 = hgo[(size_t)m * 512 + c], o1 = hgo[(size_t)m * 512 + c + 1];
        const float ms = wave_sum(o0 * o0 + o1 * o1) * (1.f / 128.f);
        const float rs = rsqrtf(ms + 1e-6f);
        const float og0 = bf2f(z[(size_t)m * NIN + 1024 + 1536 + c]), og1 = bf2f(z[(size_t)m * NIN + 1024 + 1536 + c + 1]);
        ob[(size_t)m * D + 256 + c] = f2bf(o0 * rs * norm_g[c] * siluf_(og0));
        ob[(size_t)m * D + 256 + c + 1] = f2bf(o1 * rs * norm_g[c + 1] * siluf_(og1));
    }
}

__global__ __launch_bounds__(256) void k_cm_p(const bf16* __restrict__ z, const float* __restrict__ ws  , const float* __restrict__ bs  ,
                                              const float* __restrict__ ln_g, const float* __restrict__ ln_b, bf16* __restrict__ ob) {
    __shared__ float vn[128][64];
    const int h = blockIdx.x & 3, ch = blockIdx.x >> 2;
    const int m0 = ch * 128, tid = threadIdx.x, lane = tid & 63, w = tid >> 6;
    for (int s = w; s < 128; s += 4) {
        const float val = geluf_(bf2f(z[(size_t)(m0 + s) * NIN + 3072 + 256 + h * 64 + lane]));
        const float mean = wave_sum(val) * (1.f / 64.f); const float d = val - mean; const float var = wave_sum(d * d) * (1.f / 64.f);
        vn[s][lane] = d * rsqrtf(var + 1e-5f) * ln_g[h * 64 + lane] + ln_b[h * 64 + lane];
    }
    __syncthreads();
    for (int t = w; t < 128; t += 4) {
        float acc = bs[h * 128 + t];
        const float* wr = ws + ((size_t)h * 128 + t) * 128;
        for (int s = 0; s <= t; ++s) acc += wr[s] * vn[s][lane];
        const float u = geluf_(bf2f(z[(size_t)(m0 + t) * NIN + 3072 + h * 64 + lane]));
        ob[(size_t)(m0 + t) * D + 768 + h * 64 + lane] = f2bf(u * acc);
    }
}
__global__ __launch_bounds__(256) void k_cm_s(const bf16* __restrict__ z, const float* __restrict__ ws, const float* __restrict__ bs,
                                              const float* __restrict__ ln_g, const float* __restrict__ ln_b, bf16* __restrict__ ob, float* __restrict__ cmv  ) {
    const int b = blockIdx.x, c = threadIdx.x, h = c >> 6;
    float vn[DS];
#pragma unroll
    for (int t = 0; t < DS; ++t) {
        const int m = MP + b * DS + t;
        const float val = geluf_(bf2f(z[(size_t)m * NIN + 3072 + 256 + c]));
        const float mean = wave_sum(val) * (1.f / 64.f); const float d = val - mean; const float var = wave_sum(d * d) * (1.f / 64.f);
        vn[t] = d * rsqrtf(var + 1e-5f) * ln_g[c] + ln_b[c];
        cmv[((size_t)b * DS + t) * 256 + c] = vn[t];
    }
#pragma unroll
    for (int t = 0; t < DS; ++t) {
        const int m = MP + b * DS + t;
        float acc = bs[h * 128 + t];
#pragma unroll
        for (int s = 0; s <= t; ++s) acc += ws[((size_t)h * 128 + t) * 128 + s] * vn[s];
        const float u = geluf_(bf2f(z[(size_t)m * NIN + 3072 + c]));
        ob[(size_t)m * D + 768 + c] = f2bf(u * acc);
    }
}

extern "C" void kernel_launch(void* const* d_in, const int* in_sizes, int n_in, void* d_out, int out_size, void* d_ws, size_t ws_size, hipStream_t stream) {
    if (n_in != 34 || ws_size < WS_END) { fprintf(stderr, "kernel_launch: unexpected n_in %d or ws_size %zu\n", n_in, ws_size); return; }
    const float* const* in = (const float* const*)d_in;
    float* out = (float*)d_out; unsigned char* ws = (unsigned char*)d_ws;
    float* X = out + O_Y;
    bf16* XB = (bf16*)(ws + WS_XB); bf16* OB = (bf16*)(ws + WS_OB); bf16* HZ = (bf16*)(ws + WS_HZ);
    float* RW = (float*)(ws + WS_RW); float* RK = (float*)(ws + WS_RK); float* HG = (float*)(ws + WS_HG); float* RWO = (float*)(ws + WS_RWO); float* HGO = (float*)(ws + WS_HGO);
    static bool attr = false;
    if (!attr) { (void)hipFuncSetAttribute((const void*)k_rw_m1, hipFuncAttributeMaxDynamicSharedMemorySize, 65536); attr = true; }
    for (int l = 0; l < DEPTH; ++l) {
        bf16* wl = (bf16*)(ws + WS_W + (size_t)l * W_LAYER);
        k_transpose_w<<<dim3(2 * DFF / 32, D / 32), 256, 0, stream>>>(in[5] + (size_t)l * D * 2 * DFF, (bf16*)((char*)wl + W_1IN), D, 2 * DFF, 1);
        k_transpose_w<<<dim3(D / 32, DFF / 32), 256, 0, stream>>>(in[6] + (size_t)l * DFF * D, (bf16*)((char*)wl + W_1OUT), DFF, D, 0);
        k_transpose_w<<<dim3(NIN / 32, D / 32), 256, 0, stream>>>(in[9] + (size_t)l * D * NIN, (bf16*)((char*)wl + W_MI), D, NIN, 0);
        k_transpose_w<<<dim3(D / 32, D / 32), 256, 0, stream>>>(in[10] + (size_t)l * D * D, (bf16*)((char*)wl + W_MO), D, D, 0);
        k_transpose_w<<<dim3(2 * DFF / 32, D / 32), 256, 0, stream>>>(in[30] + (size_t)l * D * 2 * DFF, (bf16*)((char*)wl + W_2IN), D, 2 * DFF, 1);
        k_transpose_w<<<dim3(D / 32, DFF / 32), 256, 0, stream>>>(in[31] + (size_t)l * DFF * D, (bf16*)((char*)wl + W_2OUT), DFF, D, 0);
    }
    (void)hipMemcpyAsync(X, in[0], (size_t)MP * D * 4, hipMemcpyDeviceToDevice, stream);
    (void)hipMemcpyAsync(X + (size_t)MP * D, in[1], (size_t)MS * D * 4, hipMemcpyDeviceToDevice, stream);
    k_cvt_x<<<(M * D / 4 + 255) / 256, 256, 0, stream>>>(X, XB, (size_t)M * D);
    for (int l = 0; l < DEPTH; ++l) {
        const char* wl = (const char*)(ws + WS_W + (size_t)l * W_LAYER);
        k_gemm<1><<<dim3(DFF / 64, M / 64), 256, 0, stream>>>(XB, (const bf16*)(wl + W_1IN), D, 2 * DFF, HZ, nullptr, 0.f, 0.f);
        k_gemm<2><<<dim3(D / 64, M / 64), 256, 0, stream>>>(HZ, (const bf16*)(wl + W_1OUT), DFF, D, nullptr, X, ALPHA, 0.5f);
        k_ln<<<M / 4, 256, 0, stream>>>(X, XB, in[7] + l * D, in[8] + l * D);
        k_gemm<0><<<dim3(NIN / 64, M / 64), 256, 0, stream>>>(XB, (const bf16*)(wl + W_MI), D, NIN, HZ, nullptr, 0.f, 0.f);
        RwParams P{in[13] + l * 1024, in[14] + l * 256, in[15] + (size_t)l * 64 * 256, in[16] + l * 256, in[17] + (size_t)l * 64 * 256, in[18] + (size_t)l * 128 * 256, in[19] + l * 256, in[20] + l * 256, in[21] + l * 256};
        k_rw_m1<<<M / 16, 256, 65536, stream>>>(HZ, in[3] + (size_t)l * DB * 1024, P, RW, RK, out + O_RWSHP + (size_t)l * BATCH * 1024, out + O_RWSHS + (size_t)l * DB * 1024);
        k_hg_m1<<<M, 256, 0, stream>>>(HZ, in[24], l, HG);
        k_cm_p<<<BATCH * 16 * 4, 256, 0, stream>>>(HZ, in[26] + (size_t)l * 4 * 128 * 128, in[27] + l * 512, in[28] + l * 256, in[29] + l * 256, OB);
        k_cm_s<<<DB, 256, 0, stream>>>(HZ, in[26] + (size_t)l * 4 * 128 * 128, in[27] + l * 512, in[28] + l * 256, in[29] + l * 256, OB, out + O_CMV + (size_t)l * DB * DS * 256);
        k_rw_m2<<<(BATCH + DB) * 4, 64, 0, stream>>>(RW, in[2] + (size_t)l * DB * 4 * 4096, RWO, out + O_RWSP + (size_t)l * BATCH * 4 * 4096, out + O_RWSS + (size_t)l * DB * 4 * 4096);
        k_hg_m2<<<(BATCH + DB) * 8, 64, 0, stream>>>(HG, in[4] + (size_t)l * DB * 4 * 16384, HGO, out + O_HGSP + (size_t)l * BATCH * 4 * 16384, out + O_HGSS + (size_t)l * DB * 4 * 16384);
        k_m3<<<M, 256, 0, stream>>>(HZ, RW, RK, RWO, HGO, in[22] + l * 256, in[23] + l * 256, in[25] + l * 512, OB);
        k_gemm<2><<<dim3(D / 64, M / 64), 256, 0, stream>>>(OB, (const bf16*)(wl + W_MO), D, D, nullptr, X, ALPHA, 1.0f);
        k_ln<<<M / 4, 256, 0, stream>>>(X, XB, in[11] + l * D, in[12] + l * D);
        k_gemm<1><<<dim3(DFF / 64, M / 64), 256, 0, stream>>>(XB, (const bf16*)(wl + W_2IN), D, 2 * DFF, HZ, nullptr, 0.f, 0.f);
        k_gemm<2><<<dim3(D / 64, M / 64), 256, 0, stream>>>(HZ, (const bf16*)(wl + W_2OUT), DFF, D, nullptr, X, ALPHA, 0.5f);
        k_ln<<<M / 4, 256, 0, stream>>>(X, XB, in[32] + l * D, in[33] + l * D);
    }
}
```

```cpp
#include <hip/hip_runtime.h>
#include <cstdio>
#include <cstdint>
namespace pg8 {
#define PG8_LAS __attribute__((address_space(3)))
typedef unsigned short bf16_t;
typedef short bf16x8 __attribute__((ext_vector_type(8)));
typedef float f32x4 __attribute__((ext_vector_type(4)));
typedef unsigned u32x4 __attribute__((ext_vector_type(4)));
constexpr int BM = 256, BK = 64, HALF = 128, HTB = HALF * BK * 2  , STAGE_BYTES = 8 * HTB, NXCD = 8, WGM = 8;

__host__ __device__ __forceinline__ int lds_byte(int r, int c) { const int st = (r >> 4) * 2 + (c >> 5), rr = r & 15, cc = c & 31, ob = rr * 64 + cc * 2; return st * 1024 + (ob ^ (((ob >> 9) & 1) << 5)); }
__host__ __device__ __forceinline__ void stage_rc(int b, int& R, int& C) { const int st = b / 1024, sb = b % 1024, swz = sb ^ (((sb >> 9) & 1) << 5); R = (st >> 1) * 16 + swz / 64; C = (st & 1) * 32 + (swz % 64) / 2; }
__host__ __device__ __forceinline__ int perm32(int rho) { const int n = rho >> 4, i = rho & 15; return 8 * (i >> 2) + 4 * n + (i & 3); }

struct Unit { int pm, pn; };
struct Gemm { const bf16_t* A; const bf16_t* Bt; int M, N, K; };

struct StaticOrder {
    int nM, nN, nwg, G, c;
    __host__ __device__ void init(int M, int N, int G_, int c_) { nM = M / BM; nN = N / BM; nwg = nM * nN; G = G_; c = c_; }
    __host__ __device__ bool next(int i, Unit& u) const {
        const long L = (long)i * G + c; if (L >= nwg) return false;
        int wgid = (int)L; { const int q = nwg / NXCD, r = nwg % NXCD, xcd = wgid % NXCD, off = wgid / NXCD; wgid = (xcd < r ? xcd * (q + 1) : r * (q + 1) + (xcd - r) * q) + off; }
        const int nig = WGM * nN, gid = wgid / nig, fm = gid * WGM, gsz = (nM - fm) < WGM ? (nM - fm) : WGM;
        u.pm = fm + ((wgid % nig) % gsz); u.pn = (wgid % nig) / gsz; return true;
    }
    __device__ __forceinline__ void a_ready(const Unit&) const {}
    __device__ __forceinline__ void done(const Unit&) const {}
};
__device__ __forceinline__ unsigned cvt_pk_bf16(float lo, float hi) { unsigned r; asm volatile("v_cvt_pk_bf16_f32 %0, %1, %2" : "=v"(r) : "v"(lo), "v"(hi)); return r; }
__device__ __forceinline__ float silu_f(float x) { return x * __builtin_amdgcn_rcpf(1.0f + __expf(-x)); }
struct EpiSwiGLU {
    static constexpr bool PERM = true, AFTER_DRAIN = false;
    bf16_t* O; int ldc;
    __device__ __forceinline__ void operator()(const f32x4 (&acc)[2][2][4][2], const Unit& u, int wr, int wc, int fr, int fq) const {
        const int row0 = u.pm * BM + wr * 64 + fr, col0 = u.pn * HALF + wc * 32 + 8 * fq;
#pragma unroll
        for (int ai = 0; ai < 2; ++ai)
#pragma unroll
            for (int m = 0; m < 4; ++m) { bf16_t* rowp = O + (size_t)(row0 + ai * HALF + m * 16) * ldc + col0;
                const f32x4 g0 = acc[ai][0][m][0], g1 = acc[ai][0][m][1], u0 = acc[ai][1][m][0], u1 = acc[ai][1][m][1];
                u32x4 w; w.x = cvt_pk_bf16(silu_f(g0[0]) * u0[0], silu_f(g0[1]) * u0[1]); w.y = cvt_pk_bf16(silu_f(g0[2]) * u0[2], silu_f(g0[3]) * u0[3]);
                w.z = cvt_pk_bf16(silu_f(g1[0]) * u1[0], silu_f(g1[1]) * u1[1]); w.w = cvt_pk_bf16(silu_f(g1[2]) * u1[2], silu_f(g1[3]) * u1[3]);
                *(u32x4*)rowp = w; }
    }
};
struct EpiStoreBf16 {
    static constexpr bool PERM = true, AFTER_DRAIN = false;
    bf16_t* O; int ldc;
    __device__ __forceinline__ void operator()(const f32x4 (&acc)[2][2][4][2], const Unit& u, int wr, int wc, int fr, int fq) const {
        const int row0 = u.pm * BM + wr * 64 + fr, col0 = u.pn * BM + wc * 32 + 8 * fq;
#pragma unroll
        for (int ai = 0; ai < 2; ++ai)
#pragma unroll
            for (int m = 0; m < 4; ++m) { bf16_t* rowp = O + (size_t)(row0 + ai * HALF + m * 16) * ldc + col0;
#pragma unroll
                for (int bj = 0; bj < 2; ++bj) { const f32x4 v0 = acc[ai][bj][m][0], v1 = acc[ai][bj][m][1];
                    u32x4 w; w.x = cvt_pk_bf16(v0[0], v0[1]); w.y = cvt_pk_bf16(v0[2], v0[3]); w.z = cvt_pk_bf16(v1[0], v1[1]); w.w = cvt_pk_bf16(v1[2], v1[3]);
                    *(u32x4*)(rowp + bj * HALF) = w; } }
    }
};
struct EpiResidual {
    static constexpr bool PERM = false, AFTER_DRAIN = false;
    float* X; int ldc; float alpha, scale;
    __device__ __forceinline__ void operator()(const f32x4 (&acc)[2][2][4][2], const Unit& u, int wr, int wc, int fr, int fq) const {
        const int row0 = u.pm * BM + wr * 64 + fr, col0 = u.pn * BM + wc * 32 + 4 * fq;
#pragma unroll
        for (int ai = 0; ai < 2; ++ai)
#pragma unroll
            for (int m = 0; m < 4; ++m) { float* rowp = X + (size_t)(row0 + ai * HALF + m * 16) * ldc + col0;
                f32x4 xv[2][2];
#pragma unroll
                for (int bj = 0; bj < 2; ++bj)
#pragma unroll
                    for (int n = 0; n < 2; ++n) xv[bj][n] = *(const f32x4*)(rowp + bj * HALF + n * 16);
#pragma unroll
                for (int bj = 0; bj < 2; ++bj)
#pragma unroll
                    for (int n = 0; n < 2; ++n) *(f32x4*)(rowp + bj * HALF + n * 16) = xv[bj][n] * alpha + acc[ai][bj][m][n] * scale;
                asm volatile("" ::: "memory"); }
    }
};
template <class Epi, class Sched, bool ALIGN_EPI = false, bool SP2 = false>
__device__ __forceinline__ void gemm_phase(PG8_LAS unsigned char* lds, const Gemm g, const Sched& S, const Epi& E, const int tid) {
    const int wid = __builtin_amdgcn_readfirstlane(tid >> 6), lane = tid & 63, wr = wid >> 2, wc = wid & 3, fr = lane & 15, fq = lane >> 4;
    const int K = g.K, nt = K / BK;
    unsigned voffA[2], voffB[2];
#pragma unroll
    for (int i = 0; i < 2; ++i) { int R, C; stage_rc(tid * 16 + i * 8192, R, C); const int Rb = Epi::PERM ? ((R & ~31) + perm32(R & 31)) : R;
        voffA[i] = (unsigned)(R * K + C) * 2u; voffB[i] = (unsigned)(Rb * K + C) * 2u; }
    const size_t kstep = (size_t)(BK * 2);
    const size_t hstep = (size_t)HALF * K * 2;
    const size_t tstep = 2 * hstep;
    const unsigned ldsw = (unsigned)wid * 1024u;
    const int aoff = lds_byte(wr * 64 + fr, fq * 8), boff = lds_byte(wc * 32 + fr, fq * 8);
#define PG8_SA(b, h) (((b) * 2 + (h)) * HTB)
#define PG8_SB(b, h) ((4 + (b) * 2 + (h)) * HTB)
#define PG8_STAGE(bufoff, gbase, voff) do { _Pragma("unroll") for (int _i = 0; _i < 2; ++_i) \
        __builtin_amdgcn_global_load_lds((const unsigned*)((const char*)(gbase) + (voff)[_i]), (PG8_LAS unsigned*)(lds + (bufoff) + ldsw + _i * 8192), 16, 0, 0); } while (0)
#define PG8_LDA(dst, b, h) do { _Pragma("unroll") for (int m = 0; m < 4; ++m) _Pragma("unroll") for (int k = 0; k < 2; ++k) dst[m][k] = *(const PG8_LAS bf16x8*)(lds + PG8_SA(b, h) + aoff + m * 2048 + k * 1024); } while (0)
#define PG8_LDB(dst, b, h) do { _Pragma("unroll") for (int n = 0; n < 2; ++n) _Pragma("unroll") for (int k = 0; k < 2; ++k) dst[n][k] = *(const PG8_LAS bf16x8*)(lds + PG8_SB(b, h) + boff + n * 2048 + k * 1024); } while (0)
#define PG8_MMA(ai, bj, At, Bt) do { __builtin_amdgcn_s_setprio(1); _Pragma("unroll") for (int m = 0; m < 4; ++m) _Pragma("unroll") for (int n = 0; n < 2; ++n) _Pragma("unroll") for (int k = 0; k < 2; ++k) \
        acc[ai][bj][m][n] = __builtin_amdgcn_mfma_f32_16x16x32_bf16(Bt[n][k], At[m][k], acc[ai][bj][m][n], 0, 0, 0); __builtin_amdgcn_s_setprio(0); } while (0)
#define PG8_WAIT_V(n) asm volatile("s_waitcnt vmcnt(" #n ")" ::: "memory")
#define PG8_WAIT_L(n) asm volatile("s_waitcnt lgkmcnt(" #n ")" ::: "memory")
#define PG8_BAR __builtin_amdgcn_s_barrier()
#define PG8_SCHED __builtin_amdgcn_sched_barrier(0)
    Unit cur, nxt; int ui = 0;
    if (!S.next(0, cur)) return;
    f32x4 acc[2][2][4][2];
#pragma unroll
    for (int a = 0; a < 2; ++a)
#pragma unroll
        for (int b = 0; b < 2; ++b)
#pragma unroll
            for (int m = 0; m < 4; ++m)
#pragma unroll
                for (int n = 0; n < 2; ++n) acc[a][b][m][n] = (f32x4){0.f, 0.f, 0.f, 0.f};
    bf16x8 At[4][2], B0[2][2], B1[2][2];
    const char* cA = (const char*)g.A + (size_t)cur.pm * tstep; const char* cB = (const char*)g.Bt + (size_t)cur.pn * tstep;
    S.a_ready(cur);
    if constexpr (SP2) {
        PG8_STAGE(PG8_SB(0, 0), cB, voffB); PG8_STAGE(PG8_SB(0, 1), cB + hstep, voffB); PG8_STAGE(PG8_SA(0, 0), cA, voffA); PG8_STAGE(PG8_SA(0, 1), cA + hstep, voffA);
        if (wr == 1) PG8_BAR;
        PG8_WAIT_V(2); PG8_BAR;
        PG8_STAGE(PG8_SB(1, 0), cB + kstep, voffB); PG8_STAGE(PG8_SA(1, 0), cA + kstep, voffA); PG8_STAGE(PG8_SB(1, 1), cB + hstep + kstep, voffB);
        PG8_WAIT_V(6); PG8_BAR;
    } else {
        PG8_STAGE(PG8_SB(0, 0), cB, voffB); PG8_STAGE(PG8_SA(0, 0), cA, voffA); PG8_STAGE(PG8_SB(0, 1), cB + hstep, voffB); PG8_STAGE(PG8_SA(0, 1), cA + hstep, voffA);
        if (wr == 1) PG8_BAR;
        PG8_WAIT_V(4); PG8_BAR;
        PG8_STAGE(PG8_SB(1, 0), cB + kstep, voffB); PG8_STAGE(PG8_SA(1, 0), cA + kstep, voffA); PG8_STAGE(PG8_SB(1, 1), cB + hstep + kstep, voffB);
        PG8_WAIT_V(6); PG8_BAR;
    }
    for (;;) {
        const bool has_next = S.next(ui + 1, nxt);
        const char* nA = has_next ? (const char*)g.A + (size_t)nxt.pm * tstep : cA; const char* nB = has_next ? (const char*)g.Bt + (size_t)nxt.pn * tstep : cB;
        for (int t = 0; t < nt; t += 2) {
            const bool last = (t == nt - 2);
            const char* a1 = cA + (size_t)(t + 1) * kstep;
            const char* a2 = last ? nA : cA + (size_t)(t + 2) * kstep; const char* b2 = last ? nB : cB + (size_t)(t + 2) * kstep;
            const char* a3 = a2 + kstep; const char* b3 = b2 + kstep;
            if (last && has_next) S.a_ready(nxt);
            if constexpr (SP2) {
            PG8_LDB(B0, 0, 0); PG8_LDB(B1, 0, 1); PG8_SCHED; PG8_LDA(At, 0, 0); PG8_STAGE(PG8_SA(1, 1), a1 + hstep, voffA);
            PG8_WAIT_V(8); PG8_WAIT_L(0); PG8_BAR; PG8_MMA(0, 0, At, B0); PG8_MMA(0, 1, At, B1); PG8_BAR; PG8_SCHED;
            PG8_LDA(At, 0, 1); PG8_STAGE(PG8_SB(0, 0), b2, voffB); PG8_STAGE(PG8_SB(0, 1), b2 + hstep, voffB); PG8_STAGE(PG8_SA(0, 0), a2, voffA);
            PG8_WAIT_V(8); PG8_WAIT_L(0); PG8_BAR; PG8_MMA(1, 0, At, B0); PG8_MMA(1, 1, At, B1); PG8_BAR; PG8_SCHED;
            PG8_LDB(B0, 1, 0); PG8_LDB(B1, 1, 1); PG8_SCHED; PG8_LDA(At, 1, 0); PG8_STAGE(PG8_SA(0, 1), a2 + hstep, voffA);
            PG8_WAIT_V(8); PG8_WAIT_L(0); PG8_BAR; PG8_MMA(0, 0, At, B0); PG8_MMA(0, 1, At, B1); PG8_BAR; PG8_SCHED;
            PG8_LDA(At, 1, 1); PG8_STAGE(PG8_SB(1, 0), b3, voffB); PG8_STAGE(PG8_SB(1, 1), b3 + hstep, voffB); PG8_STAGE(PG8_SA(1, 0), a3, voffA);
            PG8_WAIT_V(8); PG8_WAIT_L(0); PG8_BAR; PG8_MMA(1, 0, At, B0); PG8_MMA(1, 1, At, B1); PG8_BAR; PG8_SCHED;
            } else {
            PG8_LDB(B0, 0, 0); PG8_SCHED; PG8_LDA(At, 0, 0); PG8_STAGE(PG8_SA(1, 1), a1 + hstep, voffA);
            PG8_WAIT_L(8); PG8_BAR; PG8_WAIT_L(0); PG8_MMA(0, 0, At, B0); PG8_BAR; PG8_SCHED;
            PG8_LDB(B1, 0, 1); PG8_STAGE(PG8_SB(0, 0), b2, voffB);
            PG8_BAR; PG8_WAIT_L(0); PG8_MMA(0, 1, At, B1); PG8_BAR;
            PG8_LDA(At, 0, 1); PG8_STAGE(PG8_SA(0, 0), a2, voffA);
            PG8_BAR; PG8_WAIT_L(0); PG8_MMA(1, 0, At, B0); PG8_BAR; PG8_SCHED;
            PG8_STAGE(PG8_SB(0, 1), b2 + hstep, voffB);
            PG8_WAIT_V(6); PG8_BAR; PG8_MMA(1, 1, At, B1); PG8_BAR;
            PG8_LDB(B0, 1, 0); PG8_SCHED; PG8_LDA(At, 1, 0); PG8_STAGE(PG8_SA(0, 1), a2 + hstep, voffA);
            PG8_WAIT_L(8); PG8_BAR; PG8_WAIT_L(0); PG8_MMA(0, 0, At, B0); PG8_BAR; PG8_SCHED;
            PG8_LDB(B1, 1, 1); PG8_STAGE(PG8_SB(1, 0), b3, voffB);
            PG8_BAR; PG8_WAIT_L(0); PG8_MMA(0, 1, At, B1); PG8_BAR;
            PG8_LDA(At, 1, 1); PG8_STAGE(PG8_SA(1, 0), a3, voffA);
            PG8_BAR; PG8_WAIT_L(0); PG8_MMA(1, 0, At, B0); PG8_BAR; PG8_SCHED;
            PG8_STAGE(PG8_SB(1, 1), b3 + hstep, voffB);
            PG8_WAIT_V(6); PG8_BAR; PG8_MMA(1, 1, At, B1); PG8_BAR;
            }
        }
        if constexpr (ALIGN_EPI) { if (wr == 0) PG8_BAR; }
        if constexpr (!Epi::AFTER_DRAIN) { E(acc, cur, wr, wc, fr, fq); S.done(cur); }
        if (!has_next) break;
#pragma unroll
        for (int a = 0; a < 2; ++a)
#pragma unroll
            for (int b = 0; b < 2; ++b)
#pragma unroll
                for (int m = 0; m < 4; ++m)
#pragma unroll
                    for (int n = 0; n < 2; ++n) acc[a][b][m][n] = (f32x4){0.f, 0.f, 0.f, 0.f};
        cur = nxt; cA = nA; cB = nB; ++ui;
        if constexpr (ALIGN_EPI) { if (wr == 1) PG8_BAR; }
    }
    PG8_WAIT_V(0);
    if constexpr (!ALIGN_EPI) { if (wr == 0) PG8_BAR; }
    PG8_BAR;
    if constexpr (Epi::AFTER_DRAIN) { E.fused(acc, cur, wr, wc, fr, fq, lds, wid, lane); S.done(cur); }
#undef PG8_SA
#undef PG8_SB
#undef PG8_STAGE
#undef PG8_LDA
#undef PG8_LDB
#undef PG8_MMA
#undef PG8_WAIT_V
#undef PG8_WAIT_L
#undef PG8_BAR
#undef PG8_SCHED
}
}

#define GAS __attribute__((address_space(1)))
#define LAS __attribute__((address_space(3)))
typedef unsigned short bf16;
typedef unsigned v4u __attribute__((ext_vector_type(4)));
typedef float f32x4 __attribute__((ext_vector_type(4)));
typedef short bf16x8 __attribute__((ext_vector_type(8)));
typedef GAS unsigned gu32;
#define RLX_AGENT __ATOMIC_RELAXED, __HIP_MEMORY_SCOPE_AGENT
#define LDS_WAIT() asm volatile("s_waitcnt lgkmcnt(0)" ::: "memory")
#define VM_WAIT() asm volatile("s_waitcnt vmcnt(0)" ::: "memory")
__device__ __forceinline__ unsigned f2bf(float f) { unsigned u = __builtin_bit_cast(unsigned, f); return (u + 0x7fffu + ((u >> 16) & 1u)) >> 16; }
__device__ __forceinline__ unsigned pk2(float lo, float hi) { return f2bf(lo) | (f2bf(hi) << 16); }
__device__ __forceinline__ float bf2f(bf16 b) { return __uint_as_float(((unsigned)b) << 16); }

#define XB_TMO      128
#define XB_XCNT(j)  (256  + 64 * (j))
#define XB_XSUB(j)  (1280 + 64 * (j))
#define XB_XGEN(j)  (2304 + 64 * (j))
#define XB_TOP      3328
#define XB_TOPGEN   3392
#define XCD_BAR_WORDS 3456
#define XB_SPIN_CAP (1u << 18)

__device__ __forceinline__ unsigned xb_ld(unsigned* p)              { return __hip_atomic_load(p, __ATOMIC_RELAXED, __HIP_MEMORY_SCOPE_AGENT); }
__device__ __forceinline__ unsigned xb_add(unsigned* p, unsigned v) { return __hip_atomic_fetch_add(p, v, __ATOMIC_RELAXED, __HIP_MEMORY_SCOPE_AGENT); }
__device__ __forceinline__ unsigned xb_xcc_id() { return (unsigned)__builtin_amdgcn_s_getreg((3 << 11) | 20) & 0xFu; }
#define XB_SPIN(cond, bar) do { unsigned _sp = 0; while (cond) { __builtin_amdgcn_s_sleep(1); \
    if ((++_sp & 255u) == 0u) { if (xb_ld(&(bar)[XB_TMO])) break; if (_sp > XB_SPIN_CAP) { atomicAdd(&(bar)[XB_TMO], 1u); break; } } } } while (0)

struct XcdBarrier {
    unsigned* bar; unsigned x;
    volatile LAS unsigned* st;
};

__device__ __forceinline__ XcdBarrier xcd_barrier_post(unsigned* bar, volatile LAS unsigned* st) {
    XcdBarrier b; b.bar = bar; b.x = xb_xcc_id(); b.st = st;
    if (threadIdx.x == 0) (void)xb_add(&bar[XB_XCNT(b.x)], 1u);
    return b;
}
__device__ __forceinline__ void xcd_barrier_complete(unsigned* bar, unsigned x, unsigned& nloc, unsigned& nx) {
    const unsigned G = gridDim.x * gridDim.y * gridDim.z;
    unsigned sum, cnt, mine, sp = 0u;
    for (;;) {
        sum = 0u; cnt = 0u; mine = 0u;
#pragma unroll
        for (unsigned j = 0; j < 16; ++j) { const unsigned c = xb_ld(&bar[XB_XCNT(j)]); sum += c; cnt += (c > 0u) ? 1u : 0u; mine = (j == x) ? c : mine; }
        if (sum == G) break;
        __builtin_amdgcn_s_sleep(1);
        if ((++sp & 255u) == 0u) { if (xb_ld(&bar[XB_TMO])) break; if (sp > XB_SPIN_CAP) { atomicAdd(&bar[XB_TMO], 1u); break; } }
    }
    nloc = mine > 0u ? mine : 1u; nx = cnt > 0u ? cnt : 1u;
}

__device__ __forceinline__ void xcd_barrier(const XcdBarrier& b) {
    asm volatile("s_waitcnt vmcnt(0)" ::: "memory");
    __syncthreads();
    if (threadIdx.x == 0) {
        unsigned* bar = b.bar;
        __builtin_amdgcn_s_waitcnt(0);
        unsigned nloc = b.st[0], nx = b.st[1];
        if (nloc == 0u) { xcd_barrier_complete(bar, b.x, nloc, nx); b.st[0] = nloc; b.st[1] = nx; }
        const unsigned old = xb_add(&bar[XB_XSUB(b.x)], 1u);
        const unsigned gen = old / nloc;
        if (old + 1u == (gen + 1u) * nloc) {
            __builtin_amdgcn_fence(__ATOMIC_RELEASE, "agent");
            asm volatile("s_waitcnt vmcnt(0)" ::: "memory");
            const unsigned og = xb_add(&bar[XB_TOP], 1u);
            const unsigned tg = og / nx;
            if (og + 1u == (tg + 1u) * nx) xb_add(&bar[XB_TOPGEN], 1u);
            else XB_SPIN(xb_ld(&bar[XB_TOPGEN]) == tg, bar);
            __builtin_amdgcn_fence(__ATOMIC_ACQUIRE, "agent");
            xb_add(&bar[XB_XGEN(b.x)], 1u);
            asm volatile("s_waitcnt vmcnt(0)" ::: "memory");
        } else {
            XB_SPIN(xb_ld(&bar[XB_XGEN(b.x)]) == gen, bar);
            __builtin_amdgcn_fence(__ATOMIC_ACQUIRE, "agent");
            asm volatile("s_waitcnt vmcnt(0)" ::: "memory");
        }
    }
    __syncthreads();
}

#ifndef PG8_SP2
#define PG8_SP2 true
#endif
#ifndef PG8_ALIGN
#define PG8_ALIGN true
#endif
#ifndef MK_SPLIT
#define MK_SPLIT 0
#endif

constexpr int NWAVES = 8;
constexpr int D = 1024, BATCH = 8, SEQ = 2048, DEPTH = 2, DB = 128, DS = 4;
constexpr int MP = BATCH * SEQ, MS = DB * DS, M = MP + MS;
constexpr int DFF = 2816, NIN = 3584;
constexpr float ALPHA = 1.41421356237309515f;
constexpr size_t O_Y = 0, O_RWSP = 17301504, O_RWSHP = 17563648, O_HGSP = 17580032, O_RWSS = 18628608, O_RWSHS = 22822912, O_HGSS = 23085056, O_CMV = 39862272;
constexpr size_t MiB = 1u << 20;
constexpr size_t WS_CTL = 0, CTL_ZERO_BYTES = 1 * MiB;
constexpr size_t WS_W = 2 * MiB;
constexpr size_t W_1IN = 0, W_1OUT = 11 * MiB, W_MI = 17 * MiB, W_MO = 24 * MiB, W_2IN = 26 * MiB, W_2OUT = 37 * MiB, W_LAYER = 43 * MiB;
constexpr size_t WS_XB = 90 * MiB;
constexpr size_t WS_OB = 124 * MiB;
constexpr size_t WS_HZ = 158 * MiB;
constexpr size_t WS_RW = 276 * MiB;
constexpr size_t WS_RK = 392 * MiB;
constexpr size_t WS_HG = 393 * MiB;
constexpr size_t WS_RWO = 493 * MiB;
constexpr size_t WS_HGO = 510 * MiB;
constexpr size_t WS_END = 544 * MiB;
constexpr int CW_TMO = 0, CW_CODE = 1, CW_BAR = 4096;
constexpr int RING_OFF = 0, RING_BYTES = 131072;
constexpr int LDSCTL_OFF = RING_BYTES, MISC_OFF = LDSCTL_OFF + 320;
constexpr int LDS_BYTES = 147456;

struct Ctx { LAS unsigned char* lds; int tid, lane, wave, half, t256, G, gw, NGW; };

__device__ __forceinline__ float wave_sum(float v) {
#pragma unroll
    for (int o = 1; o < 64; o <<= 1) v += __shfl_xor(v, o);
    return v;
}
__device__ __forceinline__ float sigmoidf_(float x) { return 1.0f / (1.0f + expf(-x)); }
__device__ __forceinline__ float siluf_(float x) { return x / (1.0f + expf(-x)); }
__device__ __forceinline__ float geluf_(float x) { return 0.5f * x * (1.0f + erff(x * 0.70710678118654752f)); }
__device__ __forceinline__ float softplusf_(float x) { return x > 20.0f ? x : log1pf(expf(x)); }
__device__ __forceinline__ void row_info(int m, int& b, int& t, int& T, bool& smp) {
    if (m < MP) { smp = false; b = m / SEQ; t = m % SEQ; T = SEQ; } else { smp = true; b = (m - MP) / DS; t = (m - MP) % DS; T = DS; }
}

__device__ __forceinline__ void p0_transpose_item(const float* W, int K, int N, bf16* WT, int interleave, LAS float* scr, int item, int lane) {
    const int nblk = N / 32, kb = item / nblk, nb = item % nblk, k0 = 64 * kb, n0 = 32 * nb;
    int row0 = n0;
    if (interleave) { const int half = N / 2; const int j0 = n0 < half ? n0 : n0 - half; row0 = 256 * (j0 / 128) + (j0 % 128) + (n0 < half ? 0 : 128); }
#pragma unroll 8
    for (int i = 0; i < 32; ++i) { const int kk = 2 * i + (lane >> 5); scr[kk * 33 + (lane & 31)] = W[(size_t)(k0 + kk) * N + n0 + (lane & 31)]; }
    LDS_WAIT(); asm volatile("" ::: "memory");
    const int c = lane & 7;
#pragma unroll
    for (int j = 0; j < 4; ++j) { const int n = (lane >> 3) + 8 * j; const LAS float* s = scr + (8 * c) * 33 + n;
        v4u o; o.x = pk2(s[0 * 33], s[1 * 33]); o.y = pk2(s[2 * 33], s[3 * 33]); o.z = pk2(s[4 * 33], s[5 * 33]); o.w = pk2(s[6 * 33], s[7 * 33]);
        *(GAS v4u*)(WT + (size_t)(row0 + n) * K + k0 + 8 * c) = o; }
    LDS_WAIT(); asm volatile("" ::: "memory");
}
__device__ __forceinline__ void phase_prologue(const Ctx& C, const float* const* in, unsigned char* ws, float* X, bf16* XB) {
    LAS float* scr = (LAS float*)(C.lds + RING_OFF + C.wave * 16384);
    constexpr int I_IN = (D / 64) * (2 * DFF / 32), I_OUT = (DFF / 64) * (D / 32), I_MI = (D / 64) * (NIN / 32), I_MO = (D / 64) * (D / 32);
    constexpr int I_LAYER = 2 * I_IN + 2 * I_OUT + I_MI + I_MO;
    for (int it = C.gw; it < DEPTH * I_LAYER; it += C.NGW) {
        const int l = it / I_LAYER; int r = it % I_LAYER;
        bf16* wl = (bf16*)(ws + WS_W + (size_t)l * W_LAYER);
        if (r < I_IN) { p0_transpose_item(in[5] + (size_t)l * D * 2 * DFF, D, 2 * DFF, (bf16*)((char*)wl + W_1IN), 1, scr, r, C.lane); continue; } r -= I_IN;
        if (r < I_OUT) { p0_transpose_item(in[6] + (size_t)l * DFF * D, DFF, D, (bf16*)((char*)wl + W_1OUT), 0, scr, r, C.lane); continue; } r -= I_OUT;
        if (r < I_MI) { p0_transpose_item(in[9] + (size_t)l * D * NIN, D, NIN, (bf16*)((char*)wl + W_MI), 0, scr, r, C.lane); continue; } r -= I_MI;
        if (r < I_MO) { p0_transpose_item(in[10] + (size_t)l * D * D, D, D, (bf16*)((char*)wl + W_MO), 0, scr, r, C.lane); continue; } r -= I_MO;
        if (r < I_IN) { p0_transpose_item(in[30] + (size_t)l * D * 2 * DFF, D, 2 * DFF, (bf16*)((char*)wl + W_2IN), 1, scr, r, C.lane); continue; } r -= I_IN;
        p0_transpose_item(in[31] + (size_t)l * DFF * D, DFF, D, (bf16*)((char*)wl + W_2OUT), 0, scr, r, C.lane);
    }
    const size_t n4 = (size_t)M * D / 4, np4 = (size_t)MP * D / 4;
    for (size_t i = (size_t)blockIdx.x * 512 + C.tid; i < n4; i += (size_t)C.G * 512) {
        const f32x4 v = i < np4 ? ((const f32x4*)in[0])[i] : ((const f32x4*)in[1])[i - np4];
        ((f32x4*)X)[i] = v;
        ((unsigned long long*)XB)[i] = (unsigned long long)pk2(v.x, v.y) | ((unsigned long long)pk2(v.z, v.w) << 32);
    }
}

__device__ __forceinline__ void phase_ln(const Ctx& C, float* X, bf16* XB, const float* g, const float* b) {
    for (int row = C.gw; row < M; row += C.NGW) {
        f32x4* xr = (f32x4*)(X + (size_t)row * D) + C.lane;
        f32x4 v[4]; float s = 0.f;
#pragma unroll
        for (int j = 0; j < 4; ++j) { v[j] = xr[64 * j]; s += (v[j].x + v[j].y) + (v[j].z + v[j].w); }
        const float mean = wave_sum(s) * (1.f / D); float s2 = 0.f;
#pragma unroll
        for (int j = 0; j < 4; ++j) { v[j] = v[j] - mean; s2 += (v[j].x * v[j].x + v[j].y * v[j].y) + (v[j].z * v[j].z + v[j].w * v[j].w); }
        const float rstd = rsqrtf(wave_sum(s2) * (1.f / D) + 1e-5f);
#pragma unroll
        for (int j = 0; j < 4; ++j) {
            const f32x4 gg = ((const f32x4*)g)[C.lane + 64 * j], bb = ((const f32x4*)b)[C.lane + 64 * j];
            const f32x4 o = v[j] * rstd * gg + bb;
            xr[64 * j] = o;
            ((unsigned long long*)(XB + (size_t)row * D))[C.lane + 64 * j] = (unsigned long long)pk2(o.x, o.y) | ((unsigned long long)pk2(o.z, o.w) << 32);
        }
    }
}

struct RwParams { const float *mu, *w0, *w_w2, *a0, *a_w2, *g_w2, *k_k, *k_a, *r_k; };
__device__ __forceinline__ void rw_m1_pair(const Ctx& C, int pair, const bf16* z, const float* shift_s, const RwParams& P, float* ops, float* rk, float* sh_p, float* sh_s) {
    LAS float* zs = (LAS float*)(C.lds + RING_OFF + C.half * 65536);
    const int tid = C.t256, m0 = (2 * pair + C.half) * 16;
    for (int i = 0; i < 16; ++i) {
        const int m = m0 + i; int b, t, T; bool smp; row_info(m, b, t, T, smp);
#pragma unroll
        for (int q = 0; q < 4; ++q) {
            const int c = tid + 256 * q;
            const float zc = bf2f(z[(size_t)m * NIN + c]);
            float zp;
            if (t == 0) zp = smp ? shift_s[(size_t)b * 1024 + c] : 0.f; else zp = bf2f(z[(size_t)(m - 1) * NIN + c]);
            float v = zc + (zp - zc) * P.mu[c];
            if (c >= 768 && c < 832) v = tanhf(v);
            if (c >= 896) v = sigmoidf_(v);
            zs[i * 1024 + c] = v;
            if (t == T - 1) { if (smp) sh_s[(size_t)b * 1024 + c] = zc; else sh_p[(size_t)b * 1024 + c] = zc; }
        }
    }
    __syncthreads();
    const int c = tid;
    float aw[16], aa[16], ag[16];
#pragma unroll
    for (int i = 0; i < 16; ++i) { aw[i] = 0.f; aa[i] = 0.f; ag[i] = 0.f; }
    for (int j = 0; j < 64; ++j) {
        const float wv = P.w_w2[j * 256 + c], av = P.a_w2[j * 256 + c];
#pragma unroll
        for (int i = 0; i < 16; ++i) { aw[i] += zs[i * 1024 + 768 + j] * wv; aa[i] += zs[i * 1024 + 832 + j] * av; }
    }
    for (int j = 0; j < 128; ++j) {
        const float gv = P.g_w2[j * 256 + c];
#pragma unroll
        for (int i = 0; i < 16; ++i) ag[i] += zs[i * 1024 + 896 + j] * gv;
    }
    const float w0 = P.w0[c], a0 = P.a0[c], kkc = P.k_k[c], kac = P.k_a[c], rkc = P.r_k[c];
#pragma unroll
    for (int i = 0; i < 16; ++i) {
        const int m = m0 + i;
        const float r = zs[i * 1024 + c], k = zs[i * 1024 + 256 + c], v = zs[i * 1024 + 512 + c];
        const float wlog = -softplusf_(-(w0 + aw[i])) - 0.5f;
        const float decay = expf(-expf(wlog));
        const float a = sigmoidf_(a0 + aa[i]);
        float kk = k * kkc;
        const float ss = wave_sum(kk * kk);
        kk = kk / fmaxf(sqrtf(ss), 1e-12f);
        const float k2 = k * (1.0f + (a - 1.0f) * kac);
        const float rks = wave_sum(r * k2 * rkc);
        float* o = ops + (size_t)m * 1792 + c;
        o[0] = r; o[256] = decay; o[512] = k2; o[768] = v; o[1024] = kk; o[1280] = kk * a; o[1536] = ag[i];
        if ((tid & 63) == 0) rk[(size_t)m * 4 + (tid >> 6)] = rks;
    }
    __syncthreads();
}
__device__ __forceinline__ void hg_m1_row(int m, int t256, const bf16* z, const float* logits, int layer, float* hg) {
    for (int c = t256; c < 512; c += 256) {
        const bf16* zr = z + (size_t)m * NIN + 1024;
        const float q = bf2f(zr[c]), fz = bf2f(zr[512 + c]), iv = bf2f(zr[1024 + c]);
        float lb = 0.f;
        if (layer == 1) { const float l0 = logits[c], l1 = logits[512 + c]; lb = 1.0f / (1.0f + expf(l0 - l1)); }
        const float f = lb + (1.0f - lb) * sigmoidf_(fz);
        float* o = hg + (size_t)m * 1536;
        o[c] = siluf_(q); o[512 + c] = f; o[1024 + c] = iv;
    }
}
__device__ __forceinline__ void cm_p_pair(const Ctx& C, int pair, const bf16* z, const float* ws_, const float* bs, const float* ln_g, const float* ln_b, bf16* ob) {
    LAS float* vn = (LAS float*)(C.lds + RING_OFF + C.half * 32768);
    const int item = 2 * pair + C.half, h = item & 3, ch = item >> 2;
    const int m0 = ch * 128, lane = C.lane, w = C.t256 >> 6;
    for (int s = w; s < 128; s += 4) {
        const float val = geluf_(bf2f(z[(size_t)(m0 + s) * NIN + 3072 + 256 + h * 64 + lane]));
        const float mean = wave_sum(val) * (1.f / 64.f); const float d = val - mean; const float var = wave_sum(d * d) * (1.f / 64.f);
        vn[s * 64 + lane] = d * rsqrtf(var + 1e-5f) * ln_g[h * 64 + lane] + ln_b[h * 64 + lane];
    }
    __syncthreads();
    for (int t = w; t < 128; t += 4) {
        float acc = bs[h * 128 + t];
        const float* wr = ws_ + ((size_t)h * 128 + t) * 128;
        for (int s = 0; s <= t; ++s) acc += wr[s] * vn[s * 64 + lane];
        const float u = geluf_(bf2f(z[(size_t)(m0 + t) * NIN + 3072 + h * 64 + lane]));
        ob[(size_t)(m0 + t) * D + 768 + h * 64 + lane] = (bf16)f2bf(u * acc);
    }
    __syncthreads();
}
__device__ __forceinline__ void cm_s_seq(int b, int c, const bf16* z, const float* ws_, const float* bs, const float* ln_g, const float* ln_b, bf16* ob, float* cmv) {
    const int h = c >> 6;
    float vn[DS];
#pragma unroll
    for (int t = 0; t < DS; ++t) {
        const int m = MP + b * DS + t;
        const float val = geluf_(bf2f(z[(size_t)m * NIN + 3072 + 256 + c]));
        const float mean = wave_sum(val) * (1.f / 64.f); const float d = val - mean; const float var = wave_sum(d * d) * (1.f / 64.f);
        vn[t] = d * rsqrtf(var + 1e-5f) * ln_g[c] + ln_b[c];
        cmv[((size_t)b * DS + t) * 256 + c] = vn[t];
    }
#pragma unroll
    for (int t = 0; t < DS; ++t) {
        const int m = MP + b * DS + t;
        float acc = bs[h * 128 + t];
#pragma unroll
        for (int s = 0; s <= t; ++s) acc += ws_[((size_t)h * 128 + t) * 128 + s] * vn[s];
        const float u = geluf_(bf2f(z[(size_t)m * NIN + 3072 + c]));
        ob[(size_t)m * D + 768 + c] = (bf16)f2bf(u * acc);
    }
}
__device__ __forceinline__ void rw_m2_task(int task, int lane, const float* ops, const float* S0, float* rawo, float* Sp, float* Ss) {
    int seq = task >> 2; const int h = task & 3;
    const bool smp = seq >= BATCH; if (smp) seq -= BATCH;
    const int T = smp ? DS : SEQ; const int mbase = smp ? MP + seq * DS : seq * SEQ;
    float S[64];
    if (smp) {
#pragma unroll
        for (int k = 0; k < 64; ++k) S[k] = S0[(((size_t)seq * 4 + h) * 64 + lane) * 64 + k];
    } else {
#pragma unroll
        for (int k = 0; k < 64; ++k) S[k] = 0.f;
    }
    for (int t = 0; t < T; ++t) {
        const float* op = ops + (size_t)(mbase + t) * 1792 + h * 64;
        float sa = 0.f;
#pragma unroll
        for (int k = 0; k < 64; ++k) sa -= S[k] * op[1024 + k];
        const float vv = op[768 + lane];
        float o = 0.f;
#pragma unroll
        for (int k = 0; k < 64; ++k) { S[k] = S[k] * op[256 + k] + sa * op[1280 + k] + vv * op[512 + k]; o += S[k] * op[k]; }
        rawo[(size_t)(mbase + t) * 256 + h * 64 + lane] = o;
    }
    float* out = (smp ? Ss : Sp) + (((size_t)seq * 4 + h) * 64 + lane) * 64;
#pragma unroll
    for (int k = 0; k < 64; ++k) out[k] = S[k];
}
__device__ __forceinline__ void hg_m2_task(int task, int lane, const float* hg, const float* S0, float* rawo, float* Sp, float* Ss) {
    const int vh = task & 1, h = (task >> 1) & 3; int seq = task >> 3;
    const bool smp = seq >= BATCH; if (smp) seq -= BATCH;
    const int T = smp ? DS : SEQ; const int mbase = smp ? MP + seq * DS : seq * SEQ;
    const int v = vh * 64 + lane;
    float S[128];
    if (smp) {
#pragma unroll
        for (int k = 0; k < 128; ++k) S[k] = S0[(((size_t)seq * 4 + h) * 128 + k) * 128 + v];
    } else {
#pragma unroll
        for (int k = 0; k < 128; ++k) S[k] = 0.f;
    }
    for (int t = 0; t < T; ++t) {
        const float* op = hg + (size_t)(mbase + t) * 1536 + h * 128;
        const float iv = op[1024 + v];
        float o = 0.f;
#pragma unroll
        for (int k = 0; k < 128; ++k) { const float f = op[512 + k]; S[k] = f * S[k] + (1.0f - f) * iv; o += op[k] * S[k]; }
        rawo[(size_t)(mbase + t) * 512 + h * 128 + v] = o;
    }
    float* out = (smp ? Ss : Sp) + ((size_t)seq * 4 + h) * 16384 + v;
#pragma unroll
    for (int k = 0; k < 128; ++k) out[(size_t)k * 128] = S[k];
}
__device__ __forceinline__ void m3_row(int m, int tid, const bf16* z, const float* ops, const float* rk, const float* rwo, const float* hgo,
                                       const float* gn_g, const float* gn_b, const float* norm_g, bf16* ob) {
    const int h = tid >> 6;
    {
        const float o = rwo[(size_t)m * 256 + tid];
        const float mean = wave_sum(o) * (1.f / 64.f); const float d = o - mean; const float var = wave_sum(d * d) * (1.f / 64.f);
        float on = d * rsqrtf(var + 64e-5f) * gn_g[tid] + gn_b[tid];
        const float* op = ops + (size_t)m * 1792;
        on += rk[(size_t)m * 4 + h] * op[768 + tid];
        on *= op[1536 + tid];
        ob[(size_t)m * D + tid] = (bf16)f2bf(on);
    }
    {
        const int c = 2 * tid;
        const float o0 = hgo[(size_t)m * 512 + c], o1 = hgo[(size_t)m * 512 + c + 1];
        const float ms = wave_sum(o0 * o0 + o1 * o1) * (1.f / 128.f);
        const float rs = rsqrtf(ms + 1e-6f);
        const float og0 = bf2f(z[(size_t)m * NIN + 1024 + 1536 + c]), og1 = bf2f(z[(size_t)m * NIN + 1024 + 1536 + c + 1]);
        *(unsigned*)(ob + (size_t)m * D + 256 + c) = pk2(o0 * rs * norm_g[c] * siluf_(og0), o1 * rs * norm_g[c + 1] * siluf_(og1));
    }
}

constexpr int PH_PER_LAYER = 12, N_PHASES = 1 + DEPTH * PH_PER_LAYER;
struct Args { const float* in[34]; float* out; unsigned char* ws; int ph_lo, ph_hi; };
__global__ void __launch_bounds__(NWAVES * 64, 2) mk_fwd(Args args) {
    extern __shared__ __attribute__((aligned(16))) unsigned char lds_raw[];
    Ctx C;
    C.lds = (LAS unsigned char*)lds_raw;
    C.tid = threadIdx.x; C.lane = C.tid & 63; C.wave = __builtin_amdgcn_readfirstlane(C.tid >> 6); C.half = C.wave >> 2; C.t256 = C.tid & 255;
    C.G = gridDim.x; C.gw = C.wave * C.G + blockIdx.x; C.NGW = C.G * NWAVES;
#define REFRESH_CTX() do { int t_ = threadIdx.x; asm volatile("" : "+v"(t_)); C.tid = t_; C.lane = t_ & 63; C.wave = __builtin_amdgcn_readfirstlane(t_ >> 6); C.half = C.wave >> 2; C.t256 = t_ & 255; \
        C.gw = C.wave * C.G + blockIdx.x; } while (0)
    volatile LAS unsigned* MISC = (volatile LAS unsigned*)(C.lds + MISC_OFF);
    unsigned char* ws = args.ws; const float* const* in = args.in; float* out = args.out;
    gu32* ctl = (gu32*)(ws + WS_CTL);
    for (int u = C.tid; u < (LDS_BYTES - LDSCTL_OFF) / 4; u += NWAVES * 64) ((LAS unsigned*)(C.lds + LDSCTL_OFF))[u] = 0u;
    __syncthreads();
    XcdBarrier bar; bar.bar = (unsigned*)(ctl + CW_BAR); bar.x = 0; bar.st = nullptr;
    if (!MK_SPLIT) bar = xcd_barrier_post((unsigned*)(ctl + CW_BAR), MISC + 8);
    const int lo = args.ph_lo, hi = args.ph_hi;
    float* X = out + O_Y;
    bf16* XB = (bf16*)(ws + WS_XB); bf16* OB = (bf16*)(ws + WS_OB); bf16* HZ = (bf16*)(ws + WS_HZ);
    float* RW = (float*)(ws + WS_RW); float* RK = (float*)(ws + WS_RK); float* HG = (float*)(ws + WS_HG); float* RWO = (float*)(ws + WS_RWO); float* HGO = (float*)(ws + WS_HGO);

    for (int ph = lo; ph < hi; ++ph) {
        REFRESH_CTX();
        if (ph == 0) {
            phase_prologue(C, in, ws, X, XB);
        } else {
            const int l = (ph - 1) / PH_PER_LAYER, p = (ph - 1) % PH_PER_LAYER;
            const char* wl = (const char*)(ws + WS_W + (size_t)l * W_LAYER);
            if (p == 0 || p == 9) {
                pg8::Gemm g{XB, (const bf16*)(wl + (p == 0 ? W_1IN : W_2IN)), M, 2 * DFF, D}; pg8::StaticOrder S; S.init(M, 2 * DFF, C.G, (int)blockIdx.x);
                pg8::EpiSwiGLU E{HZ, DFF};
                pg8::gemm_phase<pg8::EpiSwiGLU, pg8::StaticOrder, PG8_ALIGN, PG8_SP2>(C.lds + RING_OFF, g, S, E, C.tid);
            } else if (p == 1 || p == 10) {
                pg8::Gemm g{HZ, (const bf16*)(wl + (p == 1 ? W_1OUT : W_2OUT)), M, D, DFF}; pg8::StaticOrder S; S.init(M, D, C.G, (int)blockIdx.x);
                pg8::EpiResidual E{X, D, ALPHA, 0.5f};
                pg8::gemm_phase<pg8::EpiResidual, pg8::StaticOrder, PG8_ALIGN, PG8_SP2>(C.lds + RING_OFF, g, S, E, C.tid);
            } else if (p == 2 || p == 8 || p == 11) {
                const int gi = p == 2 ? 7 : (p == 8 ? 11 : 32);
                phase_ln(C, X, XB, in[gi] + l * D, in[gi + 1] + l * D);
            } else if (p == 3) {
                pg8::Gemm g{XB, (const bf16*)(wl + W_MI), M, NIN, D}; pg8::StaticOrder S; S.init(M, NIN, C.G, (int)blockIdx.x);
                pg8::EpiStoreBf16 E{HZ, NIN};
                pg8::gemm_phase<pg8::EpiStoreBf16, pg8::StaticOrder, PG8_ALIGN, PG8_SP2>(C.lds + RING_OFF, g, S, E, C.tid);
            } else if (p == 4) {
                RwParams P{in[13] + l * 1024, in[14] + l * 256, in[15] + (size_t)l * 64 * 256, in[16] + l * 256, in[17] + (size_t)l * 64 * 256, in[18] + (size_t)l * 128 * 256, in[19] + l * 256, in[20] + l * 256, in[21] + l * 256};
                for (int pr = blockIdx.x; pr < M / 32; pr += C.G)
                    rw_m1_pair(C, pr, HZ, in[3] + (size_t)l * DB * 1024, P, RW, RK, out + O_RWSHP + (size_t)l * BATCH * 1024, out + O_RWSHS + (size_t)l * DB * 1024);
                for (int pr = blockIdx.x; pr < BATCH * 16 * 4 / 2; pr += C.G)
                    cm_p_pair(C, pr, HZ, in[26] + (size_t)l * 4 * 128 * 128, in[27] + l * 512, in[28] + l * 256, in[29] + l * 256, OB);
                for (int m = blockIdx.x * 2 + C.half; m < M; m += 2 * C.G) hg_m1_row(m, C.t256, HZ, in[24], l, HG);
                for (int b = blockIdx.x * 2 + C.half; b < DB; b += 2 * C.G)
                    cm_s_seq(b, C.t256, HZ, in[26] + (size_t)l * 4 * 128 * 128, in[27] + l * 512, in[28] + l * 256, in[29] + l * 256, OB, out + O_CMV + (size_t)l * DB * DS * 256);
            } else if (p == 5) {
                const int NT_RWP = BATCH * 4, NT_HGP = BATCH * 8, NT_RWS = DB * 4, NT_HGS = DB * 8;
                for (int task = C.gw; task < NT_RWP + NT_HGP + NT_RWS + NT_HGS; task += C.NGW) {
                    int t = task;
                    if (t < NT_RWP) { rw_m2_task(t, C.lane, RW, in[2] + (size_t)l * DB * 4 * 4096, RWO, out + O_RWSP + (size_t)l * BATCH * 4 * 4096, out + O_RWSS + (size_t)l * DB * 4 * 4096); continue; } t -= NT_RWP;
                    if (t < NT_HGP) { hg_m2_task(t, C.lane, HG, in[4] + (size_t)l * DB * 4 * 16384, HGO, out + O_HGSP + (size_t)l * BATCH * 4 * 16384, out + O_HGSS + (size_t)l * DB * 4 * 16384); continue; } t -= NT_HGP;
                    if (t < NT_RWS) { rw_m2_task(t + NT_RWP, C.lane, RW, in[2] + (size_t)l * DB * 4 * 4096, RWO, out + O_RWSP + (size_t)l * BATCH * 4 * 4096, out + O_RWSS + (size_t)l * DB * 4 * 4096); continue; } t -= NT_RWS;
                    hg_m2_task(t + NT_HGP, C.lane, HG, in[4] + (size_t)l * DB * 4 * 16384, HGO, out + O_HGSP + (size_t)l * BATCH * 4 * 16384, out + O_HGSS + (size_t)l * DB * 4 * 16384);
                }
            } else if (p == 6) {
                for (int m = blockIdx.x * 2 + C.half; m < M; m += 2 * C.G)
                    m3_row(m, C.t256, HZ, RW, RK, RWO, HGO, in[22] + l * 256, in[23] + l * 256, in[25] + l * 512, OB);
            } else if (p == 7) {
                pg8::Gemm g{OB, (const bf16*)(wl + W_MO), M, D, D}; pg8::StaticOrder S; S.init(M, D, C.G, (int)blockIdx.x);
                pg8::EpiResidual E{X, D, ALPHA, 1.0f};
                pg8::gemm_phase<pg8::EpiResidual, pg8::StaticOrder, PG8_ALIGN, PG8_SP2>(C.lds + RING_OFF, g, S, E, C.tid);
            }
        }
        if (ph + 1 < hi) xcd_barrier(bar);
    }
}

extern "C" void kernel_launch(void* const* d_in, const int* in_sizes, int n_in, void* d_out, int out_size, void* d_ws, size_t ws_size, hipStream_t stream) {
    static int grid = 0;
    if (grid == 0) {
        if (n_in != 34 || ws_size < WS_END) { fprintf(stderr, "kernel_launch: unexpected n_in %d or ws_size %zu; nothing launched\n", n_in, ws_size); grid = -1; return; }
        int dev = 0, cus = 0, per_cu = 0;
        if (hipGetDevice(&dev) != hipSuccess || hipDeviceGetAttribute(&cus, hipDeviceAttributeMultiprocessorCount, dev) != hipSuccess) { grid = -1; return; }
        if (hipFuncSetAttribute((const void*)mk_fwd, hipFuncAttributeMaxDynamicSharedMemorySize, LDS_BYTES) != hipSuccess) { fprintf(stderr, "kernel_launch: hipFuncSetAttribute failed\n"); grid = -1; return; }
        if (hipOccupancyMaxActiveBlocksPerMultiprocessor(&per_cu, (const void*)mk_fwd, NWAVES * 64, LDS_BYTES) != hipSuccess || per_cu < 1) { fprintf(stderr, "kernel_launch: occupancy query reports %d workgroups per CU\n", per_cu); }
        (void)hipGetLastError();
        grid = cus;
    }
    if (grid < 0) return;
    if (hipMemsetAsync((char*)d_ws + WS_CTL, 0, CTL_ZERO_BYTES, stream) != hipSuccess) return;
    Args a{};
    for (int i = 0; i < 34; ++i) a.in[i] = (const float*)d_in[i];
    a.out = (float*)d_out; a.ws = (unsigned char*)d_ws;
#if MK_SPLIT
    for (int ph = 0; ph < N_PHASES; ++ph) { a.ph_lo = ph; a.ph_hi = ph + 1; hipLaunchKernelGGL(mk_fwd, dim3(grid), dim3(NWAVES * 64), LDS_BYTES, stream, a); }
#else
    a.ph_lo = 0; a.ph_hi = N_PHASES;
    hipLaunchKernelGGL(mk_fwd, dim3(grid), dim3(NWAVES * 64), LDS_BYTES, stream, a);
#endif
}
```

```cpp
#include <hip/hip_runtime.h>
#include <cstdio>
#include <cstdint>
namespace pg8 {
#define PG8_LAS __attribute__((address_space(3)))
typedef unsigned short bf16_t;
typedef short bf16x8 __attribute__((ext_vector_type(8)));
typedef float f32x4 __attribute__((ext_vector_type(4)));
typedef unsigned u32x4 __attribute__((ext_vector_type(4)));
constexpr int BM = 256, BK = 64, HALF = 128, HTB = HALF * BK * 2  , STAGE_BYTES = 8 * HTB, NXCD = 8, WGM = 8;

__host__ __device__ __forceinline__ int lds_byte(int r, int c) { const int st = (r >> 4) * 2 + (c >> 5), rr = r & 15, cc = c & 31, ob = rr * 64 + cc * 2; return st * 1024 + (ob ^ (((ob >> 9) & 1) << 5)); }
__host__ __device__ __forceinline__ void stage_rc(int b, int& R, int& C) { const int st = b / 1024, sb = b % 1024, swz = sb ^ (((sb >> 9) & 1) << 5); R = (st >> 1) * 16 + swz / 64; C = (st & 1) * 32 + (swz % 64) / 2; }
__host__ __device__ __forceinline__ int perm32(int rho) { const int n = rho >> 4, i = rho & 15; return 8 * (i >> 2) + 4 * n + (i & 3); }

struct Unit { int pm, pn; };
struct Gemm { const bf16_t* A; const bf16_t* Bt; int M, N, K; };

struct StaticOrder {
    int nM, nN, nwg, G, c;
    __host__ __device__ void init(int M, int N, int G_, int c_) { nM = M / BM; nN = N / BM; nwg = nM * nN; G = G_; c = c_; }
    __host__ __device__ bool next(int i, Unit& u) const {
        const long L = (long)i * G + c; if (L >= nwg) return false;
        int wgid = (int)L; { const int q = nwg / NXCD, r = nwg % NXCD, xcd = wgid % NXCD, off = wgid / NXCD; wgid = (xcd < r ? xcd * (q + 1) : r * (q + 1) + (xcd - r) * q) + off; }
        const int nig = WGM * nN, gid = wgid / nig, fm = gid * WGM, gsz = (nM - fm) < WGM ? (nM - fm) : WGM;
        u.pm = fm + ((wgid % nig) % gsz); u.pn = (wgid % nig) / gsz; return true;
    }
    __device__ __forceinline__ void a_ready(const Unit&) const {}
    __device__ __forceinline__ void done(const Unit&) const {}
};
__device__ __forceinline__ unsigned cvt_pk_bf16(float lo, float hi) { unsigned r; asm volatile("v_cvt_pk_bf16_f32 %0, %1, %2" : "=v"(r) : "v"(lo), "v"(hi)); return r; }
__device__ __forceinline__ float silu_f(float x) { return x * __builtin_amdgcn_rcpf(1.0f + __expf(-x)); }
struct EpiSwiGLU {
    static constexpr bool PERM = true, AFTER_DRAIN = false;
    bf16_t* O; int ldc;
    __device__ __forceinline__ void operator()(const f32x4 (&acc)[2][2][4][2], const Unit& u, int wr, int wc, int fr, int fq) const {
        const int row0 = u.pm * BM + wr * 64 + fr, col0 = u.pn * HALF + wc * 32 + 8 * fq;
#pragma unroll
        for (int ai = 0; ai < 2; ++ai)
#pragma unroll
            for (int m = 0; m < 4; ++m) { bf16_t* rowp = O + (size_t)(row0 + ai * HALF + m * 16) * ldc + col0;
                const f32x4 g0 = acc[ai][0][m][0], g1 = acc[ai][0][m][1], u0 = acc[ai][1][m][0], u1 = acc[ai][1][m][1];
                u32x4 w; w.x = cvt_pk_bf16(silu_f(g0[0]) * u0[0], silu_f(g0[1]) * u0[1]); w.y = cvt_pk_bf16(silu_f(g0[2]) * u0[2], silu_f(g0[3]) * u0[3]);
                w.z = cvt_pk_bf16(silu_f(g1[0]) * u1[0], silu_f(g1[1]) * u1[1]); w.w = cvt_pk_bf16(silu_f(g1[2]) * u1[2], silu_f(g1[3]) * u1[3]);
                *(u32x4*)rowp = w; }
    }
};
struct EpiStoreBf16 {
    static constexpr bool PERM = true, AFTER_DRAIN = false;
    bf16_t* O; int ldc;
    __device__ __forceinline__ void operator()(const f32x4 (&acc)[2][2][4][2], const Unit& u, int wr, int wc, int fr, int fq) const {
        const int row0 = u.pm * BM + wr * 64 + fr, col0 = u.pn * BM + wc * 32 + 8 * fq;
#pragma unroll
        for (int ai = 0; ai < 2; ++ai)
#pragma unroll
            for (int m = 0; m < 4; ++m) { bf16_t* rowp = O + (size_t)(row0 + ai * HALF + m * 16) * ldc + col0;
#pragma unroll
                for (int bj = 0; bj < 2; ++bj) { const f32x4 v0 = acc[ai][bj][m][0], v1 = acc[ai][bj][m][1];
                    u32x4 w; w.x = cvt_pk_bf16(v0[0], v0[1]); w.y = cvt_pk_bf16(v0[2], v0[3]); w.z = cvt_pk_bf16(v1[0], v1[1]); w.w = cvt_pk_bf16(v1[2], v1[3]);
                    *(u32x4*)(rowp + bj * HALF) = w; } }
    }
};
struct EpiResidual {
    static constexpr bool PERM = false, AFTER_DRAIN = false;
    float* X; int ldc; float alpha, scale;
    __device__ __forceinline__ void operator()(const f32x4 (&acc)[2][2][4][2], const Unit& u, int wr, int wc, int fr, int fq) const {
        const int row0 = u.pm * BM + wr * 64 + fr, col0 = u.pn * BM + wc * 32 + 4 * fq;
#pragma unroll
        for (int ai = 0; ai < 2; ++ai)
#pragma unroll
            for (int m = 0; m < 4; ++m) { float* rowp = X + (size_t)(row0 + ai * HALF + m * 16) * ldc + col0;
                f32x4 xv[2][2];
#pragma unroll
                for (int bj = 0; bj < 2; ++bj)
#pragma unroll
                    for (int n = 0; n < 2; ++n) xv[bj][n] = *(const f32x4*)(rowp + bj * HALF + n * 16);
#pragma unroll
                for (int bj = 0; bj < 2; ++bj)
#pragma unroll
                    for (int n = 0; n < 2; ++n) *(f32x4*)(rowp + bj * HALF + n * 16) = xv[bj][n] * alpha + acc[ai][bj][m][n] * scale;
                asm volatile("" ::: "memory"); }
    }
};
template <class Epi, class Sched, bool ALIGN_EPI = false, bool SP2 = false>
__device__ __forceinline__ void gemm_phase(PG8_LAS unsigned char* lds, const Gemm g, const Sched& S, const Epi& E, const int tid) {
    const int wid = __builtin_amdgcn_readfirstlane(tid >> 6), lane = tid & 63, wr = wid >> 2, wc = wid & 3, fr = lane & 15, fq = lane >> 4;
    const int K = g.K, nt = K / BK;
    unsigned voffA[2], voffB[2];
#pragma unroll
    for (int i = 0; i < 2; ++i) { int R, C; stage_rc(tid * 16 + i * 8192, R, C); const int Rb = Epi::PERM ? ((R & ~31) + perm32(R & 31)) : R;
        voffA[i] = (unsigned)(R * K + C) * 2u; voffB[i] = (unsigned)(Rb * K + C) * 2u; }
    const size_t kstep = (size_t)(BK * 2);
    const size_t hstep = (size_t)HALF * K * 2;
    const size_t tstep = 2 * hstep;
    const unsigned ldsw = (unsigned)wid * 1024u;
    const int aoff = lds_byte(wr * 64 + fr, fq * 8), boff = lds_byte(wc * 32 + fr, fq * 8);
#define PG8_SA(b, h) (((b) * 2 + (h)) * HTB)
#define PG8_SB(b, h) ((4 + (b) * 2 + (h)) * HTB)
#define PG8_STAGE(bufoff, gbase, voff) do { _Pragma("unroll") for (int _i = 0; _i < 2; ++_i) \
        __builtin_amdgcn_global_load_lds((const unsigned*)((const char*)(gbase) + (voff)[_i]), (PG8_LAS unsigned*)(lds + (bufoff) + ldsw + _i * 8192), 16, 0, 0); } while (0)
#define PG8_LDA(dst, b, h) do { _Pragma("unroll") for (int m = 0; m < 4; ++m) _Pragma("unroll") for (int k = 0; k < 2; ++k) dst[m][k] = *(const PG8_LAS bf16x8*)(lds + PG8_SA(b, h) + aoff + m * 2048 + k * 1024); } while (0)
#define PG8_LDB(dst, b, h) do { _Pragma("unroll") for (int n = 0; n < 2; ++n) _Pragma("unroll") for (int k = 0; k < 2; ++k) dst[n][k] = *(const PG8_LAS bf16x8*)(lds + PG8_SB(b, h) + boff + n * 2048 + k * 1024); } while (0)
#define PG8_MMA(ai, bj, At, Bt) do { __builtin_amdgcn_s_setprio(1); _Pragma("unroll") for (int m = 0; m < 4; ++m) _Pragma("unroll") for (int n = 0; n < 2; ++n) _Pragma("unroll") for (int k = 0; k < 2; ++k) \
        acc[ai][bj][m][n] = __builtin_amdgcn_mfma_f32_16x16x32_bf16(Bt[n][k], At[m][k], acc[ai][bj][m][n], 0, 0, 0); __builtin_amdgcn_s_setprio(0); } while (0)
#define PG8_WAIT_V(n) asm volatile("s_waitcnt vmcnt(" #n ")" ::: "memory")
#define PG8_WAIT_L(n) asm volatile("s_waitcnt lgkmcnt(" #n ")" ::: "memory")
#define PG8_BAR __builtin_amdgcn_s_barrier()
#define PG8_SCHED __builtin_amdgcn_sched_barrier(0)
    Unit cur, nxt; int ui = 0;
    if (!S.next(0, cur)) return;
    f32x4 acc[2][2][4][2];
#pragma unroll
    for (int a = 0; a < 2; ++a)
#pragma unroll
        for (int b = 0; b < 2; ++b)
#pragma unroll
            for (int m = 0; m < 4; ++m)
#pragma unroll
                for (int n = 0; n < 2; ++n) acc[a][b][m][n] = (f32x4){0.f, 0.f, 0.f, 0.f};
    bf16x8 At[4][2], B0[2][2], B1[2][2];
    const char* cA = (const char*)g.A + (size_t)cur.pm * tstep; const char* cB = (const char*)g.Bt + (size_t)cur.pn * tstep;
    S.a_ready(cur);
    if constexpr (SP2) {
        PG8_STAGE(PG8_SB(0, 0), cB, voffB); PG8_STAGE(PG8_SB(0, 1), cB + hstep, voffB); PG8_STAGE(PG8_SA(0, 0), cA, voffA); PG8_STAGE(PG8_SA(0, 1), cA + hstep, voffA);
        if (wr == 1) PG8_BAR;
        PG8_WAIT_V(2); PG8_BAR;
        PG8_STAGE(PG8_SB(1, 0), cB + kstep, voffB); PG8_STAGE(PG8_SA(1, 0), cA + kstep, voffA); PG8_STAGE(PG8_SB(1, 1), cB + hstep + kstep, voffB);
        PG8_WAIT_V(6); PG8_BAR;
    } else {
        PG8_STAGE(PG8_SB(0, 0), cB, voffB); PG8_STAGE(PG8_SA(0, 0), cA, voffA); PG8_STAGE(PG8_SB(0, 1), cB + hstep, voffB); PG8_STAGE(PG8_SA(0, 1), cA + hstep, voffA);
        if (wr == 1) PG8_BAR;
        PG8_WAIT_V(4); PG8_BAR;
        PG8_STAGE(PG8_SB(1, 0), cB + kstep, voffB); PG8_STAGE(PG8_SA(1, 0), cA + kstep, voffA); PG8_STAGE(PG8_SB(1, 1), cB + hstep + kstep, voffB);
        PG8_WAIT_V(6); PG8_BAR;
    }
    for (;;) {
        const bool has_next = S.next(ui + 1, nxt);
        const char* nA = has_next ? (const char*)g.A + (size_t)nxt.pm * tstep : cA; const char* nB = has_next ? (const char*)g.Bt + (size_t)nxt.pn * tstep : cB;
        for (int t = 0; t < nt; t += 2) {
            const bool last = (t == nt - 2);
            const char* a1 = cA + (size_t)(t + 1) * kstep;
            const char* a2 = last ? nA : cA + (size_t)(t + 2) * kstep; const char* b2 = last ? nB : cB + (size_t)(t + 2) * kstep;
            const char* a3 = a2 + kstep; const char* b3 = b2 + kstep;
            if (last && has_next) S.a_ready(nxt);
            if constexpr (SP2) {
            PG8_LDB(B0, 0, 0); PG8_LDB(B1, 0, 1); PG8_SCHED; PG8_LDA(At, 0, 0); PG8_STAGE(PG8_SA(1, 1), a1 + hstep, voffA);
            PG8_WAIT_V(8); PG8_WAIT_L(0); PG8_BAR; PG8_MMA(0, 0, At, B0); PG8_MMA(0, 1, At, B1); PG8_BAR; PG8_SCHED;
            PG8_LDA(At, 0, 1); PG8_STAGE(PG8_SB(0, 0), b2, voffB); PG8_STAGE(PG8_SB(0, 1), b2 + hstep, voffB); PG8_STAGE(PG8_SA(0, 0), a2, voffA);
            PG8_WAIT_V(8); PG8_WAIT_L(0); PG8_BAR; PG8_MMA(1, 0, At, B0); PG8_MMA(1, 1, At, B1); PG8_BAR; PG8_SCHED;
            PG8_LDB(B0, 1, 0); PG8_LDB(B1, 1, 1); PG8_SCHED; PG8_LDA(At, 1, 0); PG8_STAGE(PG8_SA(0, 1), a2 + hstep, voffA);
            PG8_WAIT_V(8); PG8_WAIT_L(0); PG8_BAR; PG8_MMA(0, 0, At, B0); PG8_MMA(0, 1, At, B1); PG8_BAR; PG8_SCHED;
            PG8_LDA(At, 1, 1); PG8_STAGE(PG8_SB(1, 0), b3, voffB); PG8_STAGE(PG8_SB(1, 1), b3 + hstep, voffB); PG8_STAGE(PG8_SA(1, 0), a3, voffA);
            PG8_WAIT_V(8); PG8_WAIT_L(0); PG8_BAR; PG8_MMA(1, 0, At, B0); PG8_MMA(1, 1, At, B1); PG8_BAR; PG8_SCHED;
            } else {
            PG8_LDB(B0, 0, 0); PG8_SCHED; PG8_LDA(At, 0, 0); PG8_STAGE(PG8_SA(1, 1), a1 + hstep, voffA);
            PG8_WAIT_L(8); PG8_BAR; PG8_WAIT_L(0); PG8_MMA(0, 0, At, B0); PG8_BAR; PG8_SCHED;
            PG8_LDB(B1, 0, 1); PG8_STAGE(PG8_SB(0, 0), b2, voffB);
            PG8_BAR; PG8_WAIT_L(0); PG8_MMA(0, 1, At, B1); PG8_BAR;
            PG8_LDA(At, 0, 1); PG8_STAGE(PG8_SA(0, 0), a2, voffA);
            PG8_BAR; PG8_WAIT_L(0); PG8_MMA(1, 0, At, B0); PG8_BAR; PG8_SCHED;
            PG8_STAGE(PG8_SB(0, 1), b2 + hstep, voffB);
            PG8_WAIT_V(6); PG8_BAR; PG8_MMA(1, 1, At, B1); PG8_BAR;
            PG8_LDB(B0, 1, 0); PG8_SCHED; PG8_LDA(At, 1, 0); PG8_STAGE(PG8_SA(0, 1), a2 + hstep, voffA);
            PG8_WAIT_L(8); PG8_BAR; PG8_WAIT_L(0); PG8_MMA(0, 0, At, B0); PG8_BAR; PG8_SCHED;
            PG8_LDB(B1, 1, 1); PG8_STAGE(PG8_SB(1, 0), b3, voffB);
            PG8_BAR; PG8_WAIT_L(0); PG8_MMA(0, 1, At, B1); PG8_BAR;
            PG8_LDA(At, 1, 1); PG8_STAGE(PG8_SA(1, 0), a3, voffA);
            PG8_BAR; PG8_WAIT_L(0); PG8_MMA(1, 0, At, B0); PG8_BAR; PG8_SCHED;
            PG8_STAGE(PG8_SB(1, 1), b3 + hstep, voffB);
            PG8_WAIT_V(6); PG8_BAR; PG8_MMA(1, 1, At, B1); PG8_BAR;
            }
        }
        if constexpr (ALIGN_EPI) { if (wr == 0) PG8_BAR; }
        if constexpr (!Epi::AFTER_DRAIN) { E(acc, cur, wr, wc, fr, fq); S.done(cur); }
        if (!has_next) break;
#pragma unroll
        for (int a = 0; a < 2; ++a)
#pragma unroll
            for (int b = 0; b < 2; ++b)
#pragma unroll
                for (int m = 0; m < 4; ++m)
#pragma unroll
                    for (int n = 0; n < 2; ++n) acc[a][b][m][n] = (f32x4){0.f, 0.f, 0.f, 0.f};
        cur = nxt; cA = nA; cB = nB; ++ui;
        if constexpr (ALIGN_EPI) { if (wr == 1) PG8_BAR; }
    }
    PG8_WAIT_V(0);
    if constexpr (!ALIGN_EPI) { if (wr == 0) PG8_BAR; }
    PG8_BAR;
    if constexpr (Epi::AFTER_DRAIN) { E.fused(acc, cur, wr, wc, fr, fq, lds, wid, lane); S.done(cur); }
#undef PG8_SA
#undef PG8_SB
#undef PG8_STAGE
#undef PG8_LDA
#undef PG8_LDB
#undef PG8_MMA
#undef PG8_WAIT_V
#undef PG8_WAIT_L
#undef PG8_BAR
#undef PG8_SCHED
}
}

#define GAS __attribute__((address_space(1)))
#define LAS __attribute__((address_space(3)))
typedef unsigned short bf16;
typedef unsigned v4u __attribute__((ext_vector_type(4)));
typedef float f32x4 __attribute__((ext_vector_type(4)));
typedef short bf16x8 __attribute__((ext_vector_type(8)));
typedef GAS unsigned gu32;
#define RLX_AGENT __ATOMIC_RELAXED, __HIP_MEMORY_SCOPE_AGENT
#define LDS_WAIT() asm volatile("s_waitcnt lgkmcnt(0)" ::: "memory")
#define VM_WAIT() asm volatile("s_waitcnt vmcnt(0)" ::: "memory")
__device__ __forceinline__ unsigned f2bf(float f) { unsigned u = __builtin_bit_cast(unsigned, f); return (u + 0x7fffu + ((u >> 16) & 1u)) >> 16; }
__device__ __forceinline__ unsigned pk2(float lo, float hi) { return f2bf(lo) | (f2bf(hi) << 16); }
__device__ __forceinline__ float bf2f(bf16 b) { return __uint_as_float(((unsigned)b) << 16); }

#define XB_TMO      128
#define XB_XCNT(j)  (256  + 64 * (j))
#define XB_XSUB(j)  (1280 + 64 * (j))
#define XB_XGEN(j)  (2304 + 64 * (j))
#define XB_TOP      3328
#define XB_TOPGEN   3392
#define XCD_BAR_WORDS 3456
#define XB_SPIN_CAP (1u << 18)

__device__ __forceinline__ unsigned xb_ld(unsigned* p)              { return __hip_atomic_load(p, __ATOMIC_RELAXED, __HIP_MEMORY_SCOPE_AGENT); }
__device__ __forceinline__ unsigned xb_add(unsigned* p, unsigned v) { return __hip_atomic_fetch_add(p, v, __ATOMIC_RELAXED, __HIP_MEMORY_SCOPE_AGENT); }
__device__ __forceinline__ unsigned xb_xcc_id() { return (unsigned)__builtin_amdgcn_s_getreg((3 << 11) | 20) & 0xFu; }
#define XB_SPIN(cond, bar) do { unsigned _sp = 0; while (cond) { __builtin_amdgcn_s_sleep(1); \
    if ((++_sp & 255u) == 0u) { if (xb_ld(&(bar)[XB_TMO])) break; if (_sp > XB_SPIN_CAP) { atomicAdd(&(bar)[XB_TMO], 1u); break; } } } } while (0)

struct XcdBarrier {
    unsigned* bar; unsigned x;
    volatile LAS unsigned* st;
};

__device__ __forceinline__ XcdBarrier xcd_barrier_post(unsigned* bar, volatile LAS unsigned* st) {
    XcdBarrier b; b.bar = bar; b.x = xb_xcc_id(); b.st = st;
    if (threadIdx.x == 0) (void)xb_add(&bar[XB_XCNT(b.x)], 1u);
    return b;
}
__device__ __forceinline__ void xcd_barrier_complete(unsigned* bar, unsigned x, unsigned& nloc, unsigned& nx) {
    const unsigned G = gridDim.x * gridDim.y * gridDim.z;
    unsigned sum, cnt, mine, sp = 0u;
    for (;;) {
        sum = 0u; cnt = 0u; mine = 0u;
#pragma unroll
        for (unsigned j = 0; j < 16; ++j) { const unsigned c = xb_ld(&bar[XB_XCNT(j)]); sum += c; cnt += (c > 0u) ? 1u : 0u; mine = (j == x) ? c : mine; }
        if (sum == G) break;
        __builtin_amdgcn_s_sleep(1);
        if ((++sp & 255u) == 0u) { if (xb_ld(&bar[XB_TMO])) break; if (sp > XB_SPIN_CAP) { atomicAdd(&bar[XB_TMO], 1u); break; } }
    }
    nloc = mine > 0u ? mine : 1u; nx = cnt > 0u ? cnt : 1u;
}

__device__ __forceinline__ void xcd_barrier(const XcdBarrier& b) {
    asm volatile("s_waitcnt vmcnt(0)" ::: "memory");
    __syncthreads();
    if (threadIdx.x == 0) {
        unsigned* bar = b.bar;
        __builtin_amdgcn_s_waitcnt(0);
        unsigned nloc = b.st[0], nx = b.st[1];
        if (nloc == 0u) { xcd_barrier_complete(bar, b.x, nloc, nx); b.st[0] = nloc; b.st[1] = nx; }
        const unsigned old = xb_add(&bar[XB_XSUB(b.x)], 1u);
        const unsigned gen = old / nloc;
        if (old + 1u == (gen + 1u) * nloc) {
            __builtin_amdgcn_fence(__ATOMIC_RELEASE, "agent");
            asm volatile("s_waitcnt vmcnt(0)" ::: "memory");
            const unsigned og = xb_add(&bar[XB_TOP], 1u);
            const unsigned tg = og / nx;
            if (og + 1u == (tg + 1u) * nx) xb_add(&bar[XB_TOPGEN], 1u);
            else XB_SPIN(xb_ld(&bar[XB_TOPGEN]) == tg, bar);
            __builtin_amdgcn_fence(__ATOMIC_ACQUIRE, "agent");
            xb_add(&bar[XB_XGEN(b.x)], 1u);
            asm volatile("s_waitcnt vmcnt(0)" ::: "memory");
        } else {
            XB_SPIN(xb_ld(&bar[XB_XGEN(b.x)]) == gen, bar);
            __builtin_amdgcn_fence(__ATOMIC_ACQUIRE, "agent");
            asm volatile("s_waitcnt vmcnt(0)" ::: "memory");
        }
    }
    __syncthreads();
}

#ifndef PG8_SP2
#define PG8_SP2 true
#endif
#ifndef PG8_ALIGN
#define PG8_ALIGN true
#endif
#ifndef MK_SPLIT
#define MK_SPLIT 0
#endif

constexpr int NWAVES = 8;
constexpr int D = 1024, BATCH = 8, SEQ = 2048, DEPTH = 2, DB = 128, DS = 4;
constexpr int MP = BATCH * SEQ, MS = DB * DS, M = MP + MS;
constexpr int DFF = 2816, NIN = 3584;
constexpr float ALPHA = 1.41421356237309515f;
constexpr size_t O_Y = 0, O_RWSP = 17301504, O_RWSHP = 17563648, O_HGSP = 17580032, O_RWSS = 18628608, O_RWSHS = 22822912, O_HGSS = 23085056, O_CMV = 39862272;
constexpr size_t MiB = 1u << 20;
constexpr size_t WS_CTL = 0, CTL_ZERO_BYTES = 1 * MiB;
constexpr size_t WS_W = 2 * MiB;
constexpr size_t W_1IN = 0, W_1OUT = 11 * MiB, W_MI = 17 * MiB, W_MO = 24 * MiB, W_2IN = 26 * MiB, W_2OUT = 37 * MiB, W_LAYER = 43 * MiB;
constexpr size_t WS_XB = 90 * MiB;
constexpr size_t WS_OB = 124 * MiB;
constexpr size_t WS_HZ = 158 * MiB;
constexpr size_t WS_RW = 276 * MiB;
constexpr size_t WS_RK = 392 * MiB;
constexpr size_t WS_HG = 393 * MiB;
constexpr size_t WS_QP = 397 * MiB;
constexpr size_t WS_KT = 413 * MiB;
constexpr size_t WS_VT = 429 * MiB;
constexpr size_t WS_DD = 445 * MiB;
constexpr size_t WS_AA = 447 * MiB;
constexpr size_t WS_RWO = 493 * MiB;
constexpr size_t WS_HGO = 510 * MiB;
constexpr size_t WS_END = 544 * MiB;
constexpr int CW_TMO = 0, CW_CODE = 1, CW_BAR = 4096;
constexpr int RING_OFF = 0, RING_BYTES = 131072;
constexpr int LDSCTL_OFF = RING_BYTES, MISC_OFF = LDSCTL_OFF + 320;
constexpr int LDS_BYTES = 147456;

struct Ctx { LAS unsigned char* lds; int tid, lane, wave, half, t256, G, gw, NGW; };

__device__ __forceinline__ float wave_sum(float v) {
#pragma unroll
    for (int o = 1; o < 64; o <<= 1) v += __shfl_xor(v, o);
    return v;
}
__device__ __forceinline__ float sigmoidf_(float x) { return 1.0f / (1.0f + expf(-x)); }
__device__ __forceinline__ float siluf_(float x) { return x / (1.0f + expf(-x)); }
__device__ __forceinline__ float geluf_(float x) { return 0.5f * x * (1.0f + erff(x * 0.70710678118654752f)); }
__device__ __forceinline__ float softplusf_(float x) { return x > 20.0f ? x : log1pf(expf(x)); }
__device__ __forceinline__ void row_info(int m, int& b, int& t, int& T, bool& smp) {
    if (m < MP) { smp = false; b = m / SEQ; t = m % SEQ; T = SEQ; } else { smp = true; b = (m - MP) / DS; t = (m - MP) % DS; T = DS; }
}

__device__ __forceinline__ void p0_transpose_item(const float* W, int K, int N, bf16* WT, int interleave, LAS float* scr, int item, int lane) {
    const int nblk = N / 32, kb = item / nblk, nb = item % nblk, k0 = 64 * kb, n0 = 32 * nb;
    int row0 = n0;
    if (interleave) { const int half = N / 2; const int j0 = n0 < half ? n0 : n0 - half; row0 = 256 * (j0 / 128) + (j0 % 128) + (n0 < half ? 0 : 128); }
#pragma unroll 8
    for (int i = 0; i < 32; ++i) { const int kk = 2 * i + (lane >> 5); scr[kk * 33 + (lane & 31)] = W[(size_t)(k0 + kk) * N + n0 + (lane & 31)]; }
    LDS_WAIT(); asm volatile("" ::: "memory");
    const int c = lane & 7;
#pragma unroll
    for (int j = 0; j < 4; ++j) { const int n = (lane >> 3) + 8 * j; const LAS float* s = scr + (8 * c) * 33 + n;
        v4u o; o.x = pk2(s[0 * 33], s[1 * 33]); o.y = pk2(s[2 * 33], s[3 * 33]); o.z = pk2(s[4 * 33], s[5 * 33]); o.w = pk2(s[6 * 33], s[7 * 33]);
        *(GAS v4u*)(WT + (size_t)(row0 + n) * K + k0 + 8 * c) = o; }
    LDS_WAIT(); asm volatile("" ::: "memory");
}
__device__ __forceinline__ void phase_prologue(const Ctx& C, const float* const* in, unsigned char* ws, float* X, bf16* XB) {
    LAS float* scr = (LAS float*)(C.lds + RING_OFF + C.wave * 16384);
    constexpr int I_IN = (D / 64) * (2 * DFF / 32), I_OUT = (DFF / 64) * (D / 32), I_MI = (D / 64) * (NIN / 32), I_MO = (D / 64) * (D / 32);
    constexpr int I_LAYER = 2 * I_IN + 2 * I_OUT + I_MI + I_MO;
    for (int it = C.gw; it < DEPTH * I_LAYER; it += C.NGW) {
        const int l = it / I_LAYER; int r = it % I_LAYER;
        bf16* wl = (bf16*)(ws + WS_W + (size_t)l * W_LAYER);
        if (r < I_IN) { p0_transpose_item(in[5] + (size_t)l * D * 2 * DFF, D, 2 * DFF, (bf16*)((char*)wl + W_1IN), 1, scr, r, C.lane); continue; } r -= I_IN;
        if (r < I_OUT) { p0_transpose_item(in[6] + (size_t)l * DFF * D, DFF, D, (bf16*)((char*)wl + W_1OUT), 0, scr, r, C.lane); continue; } r -= I_OUT;
        if (r < I_MI) { p0_transpose_item(in[9] + (size_t)l * D * NIN, D, NIN, (bf16*)((char*)wl + W_MI), 0, scr, r, C.lane); continue; } r -= I_MI;
        if (r < I_MO) { p0_transpose_item(in[10] + (size_t)l * D * D, D, D, (bf16*)((char*)wl + W_MO), 0, scr, r, C.lane); continue; } r -= I_MO;
        if (r < I_IN) { p0_transpose_item(in[30] + (size_t)l * D * 2 * DFF, D, 2 * DFF, (bf16*)((char*)wl + W_2IN), 1, scr, r, C.lane); continue; } r -= I_IN;
        p0_transpose_item(in[31] + (size_t)l * DFF * D, DFF, D, (bf16*)((char*)wl + W_2OUT), 0, scr, r, C.lane);
    }
    const size_t n4 = (size_t)M * D / 4, np4 = (size_t)MP * D / 4;
    for (size_t i = (size_t)blockIdx.x * 512 + C.tid; i < n4; i += (size_t)C.G * 512) {
        const f32x4 v = i < np4 ? ((const f32x4*)in[0])[i] : ((const f32x4*)in[1])[i - np4];
        ((f32x4*)X)[i] = v;
        ((unsigned long long*)XB)[i] = (unsigned long long)pk2(v.x, v.y) | ((unsigned long long)pk2(v.z, v.w) << 32);
    }
}

__device__ __forceinline__ void phase_ln(const Ctx& C, float* X, bf16* XB, const float* g, const float* b) {
    for (int row = C.gw; row < M; row += C.NGW) {
        f32x4* xr = (f32x4*)(X + (size_t)row * D) + C.lane;
        f32x4 v[4]; float s = 0.f;
#pragma unroll
        for (int j = 0; j < 4; ++j) { v[j] = xr[64 * j]; s += (v[j].x + v[j].y) + (v[j].z + v[j].w); }
        const float mean = wave_sum(s) * (1.f / D); float s2 = 0.f;
#pragma unroll
        for (int j = 0; j < 4; ++j) { v[j] = v[j] - mean; s2 += (v[j].x * v[j].x + v[j].y * v[j].y) + (v[j].z * v[j].z + v[j].w * v[j].w); }
        const float rstd = rsqrtf(wave_sum(s2) * (1.f / D) + 1e-5f);
#pragma unroll
        for (int j = 0; j < 4; ++j) {
            const f32x4 gg = ((const f32x4*)g)[C.lane + 64 * j], bb = ((const f32x4*)b)[C.lane + 64 * j];
            const f32x4 o = v[j] * rstd * gg + bb;
            xr[64 * j] = o;
            ((unsigned long long*)(XB + (size_t)row * D))[C.lane + 64 * j] = (unsigned long long)pk2(o.x, o.y) | ((unsigned long long)pk2(o.z, o.w) << 32);
        }
    }
}

struct RwParams { const float *mu, *w0, *w_w2, *a0, *a_w2, *g_w2, *k_k, *k_a, *r_k; };
__device__ __forceinline__ void rw_m1_pair(const Ctx& C, int pair, const bf16* z, const float* shift_s, const RwParams& P, float* ops, float* rk, float* sh_p, float* sh_s) {
    LAS float* zs = (LAS float*)(C.lds + RING_OFF + C.half * 65536);
    const int tid = C.t256, m0 = (2 * pair + C.half) * 16;
    for (int i = 0; i < 16; ++i) {
        const int m = m0 + i; int b, t, T; bool smp; row_info(m, b, t, T, smp);
#pragma unroll
        for (int q = 0; q < 4; ++q) {
            const int c = tid + 256 * q;
            const float zc = bf2f(z[(size_t)m * NIN + c]);
            float zp;
            if (t == 0) zp = smp ? shift_s[(size_t)b * 1024 + c] : 0.f; else zp = bf2f(z[(size_t)(m - 1) * NIN + c]);
            float v = zc + (zp - zc) * P.mu[c];
            if (c >= 768 && c < 832) v = tanhf(v);
            if (c >= 896) v = sigmoidf_(v);
            zs[i * 1024 + c] = v;
            if (t == T - 1) { if (smp) sh_s[(size_t)b * 1024 + c] = zc; else sh_p[(size_t)b * 1024 + c] = zc; }
        }
    }
    __syncthreads();
    const int c = tid;
    float aw[16], aa[16], ag[16];
#pragma unroll
    for (int i = 0; i < 16; ++i) { aw[i] = 0.f; aa[i] = 0.f; ag[i] = 0.f; }
    for (int j = 0; j < 64; ++j) {
        const float wv = P.w_w2[j * 256 + c], av = P.a_w2[j * 256 + c];
#pragma unroll
        for (int i = 0; i < 16; ++i) { aw[i] += zs[i * 1024 + 768 + j] * wv; aa[i] += zs[i * 1024 + 832 + j] * av; }
    }
    for (int j = 0; j < 128; ++j) {
        const float gv = P.g_w2[j * 256 + c];
#pragma unroll
        for (int i = 0; i < 16; ++i) ag[i] += zs[i * 1024 + 896 + j] * gv;
    }
    const float w0 = P.w0[c], a0 = P.a0[c], kkc = P.k_k[c], kac = P.k_a[c], rkc = P.r_k[c];
#pragma unroll
    for (int i = 0; i < 16; ++i) {
        const int m = m0 + i;
        const float r = zs[i * 1024 + c], k = zs[i * 1024 + 256 + c], v = zs[i * 1024 + 512 + c];
        const float wlog = -softplusf_(-(w0 + aw[i])) - 0.5f;
        const float decay = expf(-expf(wlog));
        const float a = sigmoidf_(a0 + aa[i]);
        float kk = k * kkc;
        const float ss = wave_sum(kk * kk);
        kk = kk / fmaxf(sqrtf(ss), 1e-12f);
        const float k2 = k * (1.0f + (a - 1.0f) * kac);
        const float rks = wave_sum(r * k2 * rkc);
        float* o = ops + (size_t)m * 1792 + c;
        o[0] = r; o[256] = decay; o[512] = k2; o[768] = v; o[1024] = kk; o[1280] = kk * a; o[1536] = ag[i];
        if ((tid & 63) == 0) rk[(size_t)m * 4 + (tid >> 6)] = rks;
    }
    __syncthreads();
}
__device__ __forceinline__ void hg_m1_row(int m, int t256, const bf16* z, const float* logits, int layer, float* hg) {
    for (int c = t256; c < 512; c += 256) {
        const bf16* zr = z + (size_t)m * NIN + 1024;
        const float q = bf2f(zr[c]), fz = bf2f(zr[512 + c]), iv = bf2f(zr[1024 + c]);
        float lb = 0.f;
        if (layer == 1) { const float l0 = logits[c], l1 = logits[512 + c]; lb = 1.0f / (1.0f + expf(l0 - l1)); }
        const float f = lb + (1.0f - lb) * sigmoidf_(fz);
        float* o = hg + (size_t)(m - MP) * 1536;
        o[c] = siluf_(q); o[512 + c] = f; o[1024 + c] = iv;
    }
}
__device__ __forceinline__ void cm_p_pair(const Ctx& C, int pair, const bf16* z, const float* ws_, const float* bs, const float* ln_g, const float* ln_b, bf16* ob) {
    LAS float* vn = (LAS float*)(C.lds + RING_OFF + C.half * 32768);
    const int item = 2 * pair + C.half, h = item & 3, ch = item >> 2;
    const int m0 = ch * 128, lane = C.lane, w = C.t256 >> 6;
    for (int s = w; s < 128; s += 4) {
        const float val = geluf_(bf2f(z[(size_t)(m0 + s) * NIN + 3072 + 256 + h * 64 + lane]));
        const float mean = wave_sum(val) * (1.f / 64.f); const float d = val - mean; const float var = wave_sum(d * d) * (1.f / 64.f);
        vn[s * 64 + lane] = d * rsqrtf(var + 1e-5f) * ln_g[h * 64 + lane] + ln_b[h * 64 + lane];
    }
    __syncthreads();
    for (int t = w; t < 128; t += 4) {
        float acc = bs[h * 128 + t];
        const float* wr = ws_ + ((size_t)h * 128 + t) * 128;
        for (int s = 0; s <= t; ++s) acc += wr[s] * vn[s * 64 + lane];
        const float u = geluf_(bf2f(z[(size_t)(m0 + t) * NIN + 3072 + h * 64 + lane]));
        ob[(size_t)(m0 + t) * D + 768 + h * 64 + lane] = (bf16)f2bf(u * acc);
    }
    __syncthreads();
}
__device__ __forceinline__ void cm_s_seq(int b, int c, const bf16* z, const float* ws_, const float* bs, const float* ln_g, const float* ln_b, bf16* ob, float* cmv) {
    const int h = c >> 6;
    float vn[DS];
#pragma unroll
    for (int t = 0; t < DS; ++t) {
        const int m = MP + b * DS + t;
        const float val = geluf_(bf2f(z[(size_t)m * NIN + 3072 + 256 + c]));
        const float mean = wave_sum(val) * (1.f / 64.f); const float d = val - mean; const float var = wave_sum(d * d) * (1.f / 64.f);
        vn[t] = d * rsqrtf(var + 1e-5f) * ln_g[c] + ln_b[c];
        cmv[((size_t)b * DS + t) * 256 + c] = vn[t];
    }
#pragma unroll
    for (int t = 0; t < DS; ++t) {
        const int m = MP + b * DS + t;
        float acc = bs[h * 128 + t];
#pragma unroll
        for (int s = 0; s <= t; ++s) acc += ws_[((size_t)h * 128 + t) * 128 + s] * vn[s];
        const float u = geluf_(bf2f(z[(size_t)m * NIN + 3072 + c]));
        ob[(size_t)m * D + 768 + c] = (bf16)f2bf(u * acc);
    }
}
__device__ __forceinline__ void rw_m2_task(int task, int lane, const float* ops, const float* S0, float* rawo, float* Sp, float* Ss) {
    int seq = task >> 2; const int h = task & 3;
    const bool smp = seq >= BATCH; if (smp) seq -= BATCH;
    const int T = smp ? DS : SEQ; const int mbase = smp ? MP + seq * DS : seq * SEQ;
    float S[64];
    if (smp) {
#pragma unroll
        for (int k = 0; k < 64; ++k) S[k] = S0[(((size_t)seq * 4 + h) * 64 + lane) * 64 + k];
    } else {
#pragma unroll
        for (int k = 0; k < 64; ++k) S[k] = 0.f;
    }
    for (int t = 0; t < T; ++t) {
        const float* op = ops + (size_t)(mbase + t) * 1792 + h * 64;
        float sa = 0.f;
#pragma unroll
        for (int k = 0; k < 64; ++k) sa -= S[k] * op[1024 + k];
        const float vv = op[768 + lane];
        float o = 0.f;
#pragma unroll
        for (int k = 0; k < 64; ++k) { S[k] = S[k] * op[256 + k] + sa * op[1280 + k] + vv * op[512 + k]; o += S[k] * op[k]; }
        rawo[(size_t)(mbase + t) * 256 + h * 64 + lane] = o;
    }
    float* out = (smp ? Ss : Sp) + (((size_t)seq * 4 + h) * 64 + lane) * 64;
#pragma unroll
    for (int k = 0; k < 64; ++k) out[k] = S[k];
}
__device__ __forceinline__ void hg_m2_task(int task, int lane, const float* hg, const float* S0, float* rawo, float* Sp, float* Ss) {
    const int vh = task & 1, h = (task >> 1) & 3; int seq = task >> 3;
    const bool smp = seq >= BATCH; if (smp) seq -= BATCH;
    const int T = smp ? DS : SEQ; const int mbase = smp ? MP + seq * DS : seq * SEQ;
    const int v = vh * 64 + lane;
    float S[128];
    if (smp) {
#pragma unroll
        for (int k = 0; k < 128; ++k) S[k] = S0[(((size_t)seq * 4 + h) * 128 + k) * 128 + v];
    } else {
#pragma unroll
        for (int k = 0; k < 128; ++k) S[k] = 0.f;
    }
    for (int t = 0; t < T; ++t) {
        const float* op = hg + (size_t)(mbase - MP + t) * 1536 + h * 128;
        const float iv = op[1024 + v];
        float o = 0.f;
#pragma unroll
        for (int k = 0; k < 128; ++k) { const float f = op[512 + k]; S[k] = f * S[k] + (1.0f - f) * iv; o += op[k] * S[k]; }
        rawo[(size_t)(mbase + t) * 512 + h * 128 + v] = o;
    }
    float* out = (smp ? Ss : Sp) + ((size_t)seq * 4 + h) * 16384 + v;
#pragma unroll
    for (int k = 0; k < 128; ++k) out[(size_t)k * 128] = S[k];
}

__device__ __forceinline__ int hg_perm(int k) { const int i32 = k & ~31, k5 = k & 31; return k5 < 16 ? i32 + 8 * (k5 >> 2) + (k5 & 3) : i32 + 8 * ((k5 - 16) >> 2) + 4 + (k5 & 3); }
__device__ __forceinline__ void hg_m1_pair(const Ctx& C, int pair, const bf16* z, const float* logits, int layer, bf16* QP, bf16* KT, bf16* VT, float* DD, bf16* AA) {
    constexpr int LS = 132;
    LAS float* qs = (LAS float*)(C.lds + RING_OFF + C.half * 32768);
    LAS float* kl = qs + 16 * LS;
    LAS float* cu = kl + 16 * LS;
    const int unit = 2 * pair + C.half, h = unit & 3, m0 = (unit >> 2) * 16, tid = C.t256;
    if (tid < 128) {
        const int k = tid; float lb = 0.f;
        if (layer == 1) { const float l0 = logits[h * 128 + k], l1 = logits[512 + h * 128 + k]; lb = 1.0f / (1.0f + expf(l0 - l1)); }
        float cum = 0.f;
#pragma unroll 4
        for (int t = 0; t < 16; ++t) {
            const bf16* zr = z + (size_t)(m0 + t) * NIN + 1024 + h * 128 + k;
            const float q = bf2f(zr[0]), fz = bf2f(zr[512]);
            const float f = lb + (1.0f - lb) * sigmoidf_(fz);
            cum += logf(fmaxf(f, 1e-30f));
            qs[t * LS + k] = siluf_(q); kl[t * LS + k] = 1.0f - f; cu[t * LS + k] = cum;
        }
    } else {
        const int v = tid - 128; unsigned w[8];
#pragma unroll
        for (int t = 0; t < 16; t += 2) {
            const float i0 = bf2f(z[(size_t)(m0 + t) * NIN + 1024 + 1024 + h * 128 + v]), i1 = bf2f(z[(size_t)(m0 + t + 1) * NIN + 1024 + 1024 + h * 128 + v]);
            w[t >> 1] = pk2(i0, i1);
        }
        v4u* dst = (v4u*)(VT + ((size_t)unit * 128 + v) * 16);
        dst[0] = (v4u){w[0], w[1], w[2], w[3]}; dst[1] = (v4u){w[4], w[5], w[6], w[7]};
    }
    __syncthreads();
    if (tid < 128) {
        const int k = tid; const float cl = cu[15 * LS + k]; unsigned w[8];
        DD[(size_t)unit * 128 + k] = expf(cl);
        const int pk = hg_perm(k);
#pragma unroll
        for (int t = 0; t < 16; t += 2) {
            const float c0 = cu[t * LS + k], c1 = cu[(t + 1) * LS + k];
            w[t >> 1] = pk2(kl[t * LS + k] * expf(cl - c0), kl[(t + 1) * LS + k] * expf(cl - c1));
            QP[((size_t)unit * 16 + t) * 128 + pk] = (bf16)f2bf(qs[t * LS + k] * expf(c0));
            QP[((size_t)unit * 16 + t + 1) * 128 + pk] = (bf16)f2bf(qs[(t + 1) * LS + k] * expf(c1));
        }
        v4u* dst = (v4u*)(KT + ((size_t)unit * 128 + k) * 16);
        dst[0] = (v4u){w[0], w[1], w[2], w[3]}; dst[1] = (v4u){w[4], w[5], w[6], w[7]};
    }
    {
        const int t = tid >> 4, s = tid & 15; float a = 0.f;
        if (s <= t) {
            const LAS f32x4* q4 = (const LAS f32x4*)(qs + t * LS); const LAS f32x4* ct4 = (const LAS f32x4*)(cu + t * LS);
            const LAS f32x4* k4 = (const LAS f32x4*)(kl + s * LS); const LAS f32x4* cs4 = (const LAS f32x4*)(cu + s * LS);
#pragma unroll 4
            for (int j = 0; j < 32; ++j) {
                const f32x4 q = q4[j], kk = k4[j], d = ct4[j] - cs4[j];
                a += q.x * kk.x * __expf(d.x) + q.y * kk.y * __expf(d.y) + q.z * kk.z * __expf(d.z) + q.w * kk.w * __expf(d.w);
            }
        }
        AA[(size_t)unit * 256 + tid] = (bf16)f2bf(a);
    }
    __syncthreads();
}

__device__ __forceinline__ void hg_scan_prompt(const Ctx& C, int bh, const bf16* QP, const bf16* KT, const bf16* VT, const float* DD, const bf16* AA, float* rawo, float* Sp) {
    constexpr int BUF = 14336, QROW = 272;
    LAS unsigned char* base = C.lds + RING_OFF;
    const int b = bh >> 2, h = bh & 3, tid = C.tid, lane = C.lane, w = C.wave, g = lane >> 4, fr = lane & 15;
    const int pc0 = tid, pc1 = tid + 512;
    auto src_of = [&](int pc, size_t unit) -> const v4u* {
        if (pc < 256) return (const v4u*)(QP + unit * 2048) + pc;
        if (pc < 512) return (const v4u*)(KT + unit * 2048) + (pc - 256);
        if (pc < 768) return (const v4u*)(VT + unit * 2048) + (pc - 512);
        if (pc < 800) return (const v4u*)(DD + unit * 128) + (pc - 768);
        return (const v4u*)(AA + unit * 256) + (pc - 800);
    };
    auto dst_of = [&](int pc) -> int {
        if (pc < 256) return (pc >> 4) * QROW + (pc & 15) * 16;
        if (pc < 512) return 4352 + (pc - 256) * 16;
        if (pc < 768) return 8448 + (pc - 512) * 16;
        if (pc < 800) return 12544 + (pc - 768) * 16;
        return 13056 + (pc - 800) * 16;
    };
    const int d0 = dst_of(pc0), d1 = dst_of(pc1 < 832 ? pc1 : 0);
    const size_t unit0 = ((size_t)b * 128) * 4 + h;
    f32x4 acc[8];
#pragma unroll
    for (int kt = 0; kt < 8; ++kt) acc[kt] = (f32x4){0.f, 0.f, 0.f, 0.f};
    v4u p0 = *src_of(pc0, unit0), p1 = (v4u){0u, 0u, 0u, 0u};
    if (pc1 < 832) p1 = *src_of(pc1, unit0);
    *(LAS v4u*)(base + d0) = p0; if (pc1 < 832) *(LAS v4u*)(base + d1) = p1;
    __syncthreads();
    for (int c = 0; c < SEQ / 16; ++c) {
        LAS unsigned char* buf = base + (c & 1) * BUF;
        if (c + 1 < SEQ / 16) { p0 = *src_of(pc0, unit0 + 4 * (size_t)(c + 1)); if (pc1 < 832) p1 = *src_of(pc1, unit0 + 4 * (size_t)(c + 1)); }
        const bf16x8 zero8 = (bf16x8){0, 0, 0, 0, 0, 0, 0, 0};
        bf16x8 aA = *(const LAS bf16x8*)(buf + 13056 + fr * 32 + (g & 1) * 16);
        bf16x8 bV = *(const LAS bf16x8*)(buf + 8448 + (16 * w + fr) * 32 + (g & 1) * 16);
        if (g >= 2) { aA = zero8; bV = zero8; }
        f32x4 o = __builtin_amdgcn_mfma_f32_16x16x32_bf16(aA, bV, (f32x4){0.f, 0.f, 0.f, 0.f}, 0, 0, 0);
#pragma unroll
        for (int i = 0; i < 4; ++i) {
            const bf16x8 aQ = *(const LAS bf16x8*)(buf + fr * QROW + 64 * i + 16 * g);
            const f32x4 s0 = acc[2 * i], s1 = acc[2 * i + 1];
            v4u bw; bw.x = pk2(s0[0], s0[1]); bw.y = pk2(s0[2], s0[3]); bw.z = pk2(s1[0], s1[1]); bw.w = pk2(s1[2], s1[3]);
            o = __builtin_amdgcn_mfma_f32_16x16x32_bf16(aQ, __builtin_bit_cast(bf16x8, bw), o, 0, 0, 0);
        }
#pragma unroll
        for (int kt = 0; kt < 8; ++kt) {
            bf16x8 aK = *(const LAS bf16x8*)(buf + 4352 + (16 * kt + fr) * 32 + (g & 1) * 16);
            if (g >= 2) aK = zero8;
            const f32x4 dd = *(const LAS f32x4*)(buf + 12544 + (16 * kt + 4 * g) * 4);
            acc[kt] = __builtin_amdgcn_mfma_f32_16x16x32_bf16(aK, bV, acc[kt] * dd, 0, 0, 0);
        }
        {
            float* op = rawo + ((size_t)b * SEQ + 16 * c + 4 * g) * 512 + h * 128 + 16 * w + fr;
#pragma unroll
            for (int r = 0; r < 4; ++r) op[(size_t)r * 512] = o[r];
        }
        if (c + 1 < SEQ / 16) { LAS unsigned char* nb = base + ((c + 1) & 1) * BUF; *(LAS v4u*)(nb + d0) = p0; if (pc1 < 832) *(LAS v4u*)(nb + d1) = p1; }
        __syncthreads();
    }
    float* so = Sp + ((size_t)bh * 128) * 128 + 16 * w + fr;
#pragma unroll
    for (int kt = 0; kt < 8; ++kt)
#pragma unroll
        for (int r = 0; r < 4; ++r) so[(size_t)(16 * kt + 4 * g + r) * 128] = acc[kt][r];
}

__device__ __forceinline__ float dpp_sum8(float x) {
    x += __builtin_bit_cast(float, __builtin_amdgcn_update_dpp(0, __builtin_bit_cast(int, x), 0xB1, 0xF, 0xF, true));
    x += __builtin_bit_cast(float, __builtin_amdgcn_update_dpp(0, __builtin_bit_cast(int, x), 0x4E, 0xF, 0xF, true));
    x += __builtin_bit_cast(float, __builtin_amdgcn_update_dpp(0, __builtin_bit_cast(int, x), 0x141, 0xF, 0xF, true));
    return x;
}
__device__ __forceinline__ void rw_scan_prompt(const Ctx& C, int blk, const float* ops, float* rawo, float* Sp) {
    constexpr int BUF = 24576;
    LAS unsigned char* base = C.lds + RING_OFF;
    const int bh = blk >> 1, hf = blk & 1, b = bh >> 2, h = bh & 3, lane = C.lane, w = C.wave;
    const size_t mrow0 = (size_t)b * SEQ;
    if (w >= 4) {
        const int tl = C.tid - 256;
        f32x4 p[6];
        auto load = [&](int c) {
#pragma unroll
            for (int i = 0; i < 6; ++i) { const int q = i * 256 + tl, seg = q >> 4, part = q & 15, t = seg / 6, f = seg % 6;
                p[i] = *(const f32x4*)(ops + (mrow0 + 16 * c + t) * 1792 + f * 256 + h * 64 + part * 4); }
        };
        auto store = [&](int c) {
            LAS unsigned char* nb = base + (c & 1) * BUF;
#pragma unroll
            for (int i = 0; i < 6; ++i) { const int q = i * 256 + tl; *(LAS f32x4*)(nb + q * 16) = p[i]; }
        };
        load(0); store(0);
        __syncthreads();
        for (int c = 0; c < SEQ / 16; ++c) {
            if (c + 1 < SEQ / 16) { load(c + 1); store(c + 1); }
            __syncthreads();
        }
    } else {
        const int rg = hf * 4 + w, row = rg * 8 + (lane >> 3), kq = lane & 7;
        float s[8];
#pragma unroll
        for (int j = 0; j < 8; ++j) s[j] = 0.f;
        __syncthreads();
        for (int c = 0; c < SEQ / 16; ++c) {
            const LAS unsigned char* buf = base + (c & 1) * BUF;
#pragma unroll 4
            for (int t = 0; t < 16; ++t) {
                const LAS unsigned char* st = buf + t * 1536;
                const f32x4 r0 = *(const LAS f32x4*)(st + 0 * 256 + kq * 32), r1 = *(const LAS f32x4*)(st + 0 * 256 + kq * 32 + 16);
                const f32x4 w0 = *(const LAS f32x4*)(st + 1 * 256 + kq * 32), w1 = *(const LAS f32x4*)(st + 1 * 256 + kq * 32 + 16);
                const f32x4 k0 = *(const LAS f32x4*)(st + 2 * 256 + kq * 32), k1 = *(const LAS f32x4*)(st + 2 * 256 + kq * 32 + 16);
                const float vv = *(const LAS float*)(st + 3 * 256 + row * 4);
                const f32x4 q0 = *(const LAS f32x4*)(st + 4 * 256 + kq * 32), q1 = *(const LAS f32x4*)(st + 4 * 256 + kq * 32 + 16);
                const f32x4 b0 = *(const LAS f32x4*)(st + 5 * 256 + kq * 32), b1 = *(const LAS f32x4*)(st + 5 * 256 + kq * 32 + 16);
                float sp = (s[0] * q0.x + s[1] * q0.y) + (s[2] * q0.z + s[3] * q0.w) + ((s[4] * q1.x + s[5] * q1.y) + (s[6] * q1.z + s[7] * q1.w));
                const float sa = -dpp_sum8(sp);
                s[0] = s[0] * w0.x + (sa * b0.x + vv * k0.x); s[1] = s[1] * w0.y + (sa * b0.y + vv * k0.y); s[2] = s[2] * w0.z + (sa * b0.z + vv * k0.z); s[3] = s[3] * w0.w + (sa * b0.w + vv * k0.w);
                s[4] = s[4] * w1.x + (sa * b1.x + vv * k1.x); s[5] = s[5] * w1.y + (sa * b1.y + vv * k1.y); s[6] = s[6] * w1.z + (sa * b1.z + vv * k1.z); s[7] = s[7] * w1.w + (sa * b1.w + vv * k1.w);
                float op = (s[0] * r0.x + s[1] * r0.y) + (s[2] * r0.z + s[3] * r0.w) + ((s[4] * r1.x + s[5] * r1.y) + (s[6] * r1.z + s[7] * r1.w));
                op = dpp_sum8(op);
                if (kq == 0) rawo[(mrow0 + 16 * c + t) * 256 + h * 64 + row] = op;
            }
            __syncthreads();
        }
        float* so = Sp + (((size_t)bh * 64) + row) * 64 + kq * 8;
        *(f32x4*)so = (f32x4){s[0], s[1], s[2], s[3]}; *(f32x4*)(so + 4) = (f32x4){s[4], s[5], s[6], s[7]};
    }
}

__device__ __forceinline__ void m3_row(int m, int tid, const bf16* z, const float* ops, const float* rk, const float* rwo, const float* hgo,
                                       const float* gn_g, const float* gn_b, const float* norm_g, bf16* ob) {
    const int h = tid >> 6;
    {
        const float o = rwo[(size_t)m * 256 + tid];
        const float mean = wave_sum(o) * (1.f / 64.f); const float d = o - mean; const float var = wave_sum(d * d) * (1.f / 64.f);
        float on = d * rsqrtf(var + 64e-5f) * gn_g[tid] + gn_b[tid];
        const float* op = ops + (size_t)m * 1792;
        on += rk[(size_t)m * 4 + h] * op[768 + tid];
        on *= op[1536 + tid];
        ob[(size_t)m * D + tid] = (bf16)f2bf(on);
    }
    {
        const int c = 2 * tid;
        const float o0 = hgo[(size_t)m * 512 + c], o1 = hgo[(size_t)m * 512 + c + 1];
        const float ms = wave_sum(o0 * o0 + o1 * o1) * (1.f / 128.f);
        const float rs = rsqrtf(ms + 1e-6f);
        const float og0 = bf2f(z[(size_t)m * NIN + 1024 + 1536 + c]), og1 = bf2f(z[(size_t)m * NIN + 1024 + 1536 + c + 1]);
        *(unsigned*)(ob + (size_t)m * D + 256 + c) = pk2(o0 * rs * norm_g[c] * siluf_(og0), o1 * rs * norm_g[c + 1] * siluf_(og1));
    }
}

constexpr int PH_PER_LAYER = 12, N_PHASES = 1 + DEPTH * PH_PER_LAYER;
struct Args { const float* in[34]; float* out; unsigned char* ws; int ph_lo, ph_hi; };
__global__ void __launch_bounds__(NWAVES * 64, 2) mk_fwd(Args args) {
    extern __shared__ __attribute__((aligned(16))) unsigned char lds_raw[];
    Ctx C;
    C.lds = (LAS unsigned char*)lds_raw;
    C.tid = threadIdx.x; C.lane = C.tid & 63; C.wave = __builtin_amdgcn_readfirstlane(C.tid >> 6); C.half = C.wave >> 2; C.t256 = C.tid & 255;
    C.G = gridDim.x; C.gw = C.wave * C.G + blockIdx.x; C.NGW = C.G * NWAVES;
#define REFRESH_CTX() do { int t_ = threadIdx.x; asm volatile("" : "+v"(t_)); C.tid = t_; C.lane = t_ & 63; C.wave = __builtin_amdgcn_readfirstlane(t_ >> 6); C.half = C.wave >> 2; C.t256 = t_ & 255; \
        C.gw = C.wave * C.G + blockIdx.x; } while (0)
    volatile LAS unsigned* MISC = (volatile LAS unsigned*)(C.lds + MISC_OFF);
    unsigned char* ws = args.ws; const float* const* in = args.in; float* out = args.out;
    gu32* ctl = (gu32*)(ws + WS_CTL);
    for (int u = C.tid; u < (LDS_BYTES - LDSCTL_OFF) / 4; u += NWAVES * 64) ((LAS unsigned*)(C.lds + LDSCTL_OFF))[u] = 0u;
    __syncthreads();
    XcdBarrier bar; bar.bar = (unsigned*)(ctl + CW_BAR); bar.x = 0; bar.st = nullptr;
    if (!MK_SPLIT) bar = xcd_barrier_post((unsigned*)(ctl + CW_BAR), MISC + 8);
    const int lo = args.ph_lo, hi = args.ph_hi;
    float* X = out + O_Y;
    bf16* XB = (bf16*)(ws + WS_XB); bf16* OB = (bf16*)(ws + WS_OB); bf16* HZ = (bf16*)(ws + WS_HZ);
    float* RW = (float*)(ws + WS_RW); float* RK = (float*)(ws + WS_RK); float* HG = (float*)(ws + WS_HG); bf16* QP = (bf16*)(ws + WS_QP); bf16* KT = (bf16*)(ws + WS_KT); bf16* VT = (bf16*)(ws + WS_VT); float* DD = (float*)(ws + WS_DD); bf16* AA = (bf16*)(ws + WS_AA); float* RWO = (float*)(ws + WS_RWO); float* HGO = (float*)(ws + WS_HGO);

    for (int ph = lo; ph < hi; ++ph) {
        REFRESH_CTX();
        if (ph == 0) {
            phase_prologue(C, in, ws, X, XB);
        } else {
            const int l = (ph - 1) / PH_PER_LAYER, p = (ph - 1) % PH_PER_LAYER;
            const char* wl = (const char*)(ws + WS_W + (size_t)l * W_LAYER);
            if (p == 0 || p == 9) {
                pg8::Gemm g{XB, (const bf16*)(wl + (p == 0 ? W_1IN : W_2IN)), M, 2 * DFF, D}; pg8::StaticOrder S; S.init(M, 2 * DFF, C.G, (int)blockIdx.x);
                pg8::EpiSwiGLU E{HZ, DFF};
                pg8::gemm_phase<pg8::EpiSwiGLU, pg8::StaticOrder, PG8_ALIGN, PG8_SP2>(C.lds + RING_OFF, g, S, E, C.tid);
            } else if (p == 1 || p == 10) {
                pg8::Gemm g{HZ, (const bf16*)(wl + (p == 1 ? W_1OUT : W_2OUT)), M, D, DFF}; pg8::StaticOrder S; S.init(M, D, C.G, (int)blockIdx.x);
                pg8::EpiResidual E{X, D, ALPHA, 0.5f};
                pg8::gemm_phase<pg8::EpiResidual, pg8::StaticOrder, PG8_ALIGN, PG8_SP2>(C.lds + RING_OFF, g, S, E, C.tid);
            } else if (p == 2 || p == 8 || p == 11) {
                const int gi = p == 2 ? 7 : (p == 8 ? 11 : 32);
                phase_ln(C, X, XB, in[gi] + l * D, in[gi + 1] + l * D);
            } else if (p == 3) {
                pg8::Gemm g{XB, (const bf16*)(wl + W_MI), M, NIN, D}; pg8::StaticOrder S; S.init(M, NIN, C.G, (int)blockIdx.x);
                pg8::EpiStoreBf16 E{HZ, NIN};
                pg8::gemm_phase<pg8::EpiStoreBf16, pg8::StaticOrder, PG8_ALIGN, PG8_SP2>(C.lds + RING_OFF, g, S, E, C.tid);
            } else if (p == 4) {
                RwParams P{in[13] + l * 1024, in[14] + l * 256, in[15] + (size_t)l * 64 * 256, in[16] + l * 256, in[17] + (size_t)l * 64 * 256, in[18] + (size_t)l * 128 * 256, in[19] + l * 256, in[20] + l * 256, in[21] + l * 256};
                for (int pr = blockIdx.x; pr < M / 32; pr += C.G)
                    rw_m1_pair(C, pr, HZ, in[3] + (size_t)l * DB * 1024, P, RW, RK, out + O_RWSHP + (size_t)l * BATCH * 1024, out + O_RWSHS + (size_t)l * DB * 1024);
                for (int pr = blockIdx.x; pr < BATCH * 16 * 4 / 2; pr += C.G)
                    cm_p_pair(C, pr, HZ, in[26] + (size_t)l * 4 * 128 * 128, in[27] + l * 512, in[28] + l * 256, in[29] + l * 256, OB);
                for (int pr = blockIdx.x; pr < (MP / 16) * 4 / 2; pr += C.G) hg_m1_pair(C, pr, HZ, in[24], l, QP, KT, VT, DD, AA);
                for (int m = MP + blockIdx.x * 2 + C.half; m < M; m += 2 * C.G) hg_m1_row(m, C.t256, HZ, in[24], l, HG);
                for (int b = blockIdx.x * 2 + C.half; b < DB; b += 2 * C.G)
                    cm_s_seq(b, C.t256, HZ, in[26] + (size_t)l * 4 * 128 * 128, in[27] + l * 512, in[28] + l * 256, in[29] + l * 256, OB, out + O_CMV + (size_t)l * DB * DS * 256);
            } else if (p == 5) {
                const float* rwS0 = in[2] + (size_t)l * DB * 4 * 4096; const float* hgS0 = in[4] + (size_t)l * DB * 4 * 16384;
                float* rwSp = out + O_RWSP + (size_t)l * BATCH * 4 * 4096; float* rwSs = out + O_RWSS + (size_t)l * DB * 4 * 4096;
                float* hgSp = out + O_HGSP + (size_t)l * BATCH * 4 * 16384; float* hgSs = out + O_HGSS + (size_t)l * DB * 4 * 16384;
                const int blk = blockIdx.x;
                if (blk < 64) rw_scan_prompt(C, blk, RW, RWO, rwSp);
                else if (blk < 96) hg_scan_prompt(C, blk - 64, QP, KT, VT, DD, AA, HGO, hgSp);
                else {
                    const int NT_RWS = DB * 4, NT_HGS = DB * 8;
                    for (int task = (blk - 96) + 160 * C.wave; task < NT_RWS + NT_HGS; task += 160 * NWAVES) {
                        if (task < NT_RWS) rw_m2_task(task + BATCH * 4, C.lane, RW, rwS0, RWO, rwSp, rwSs);
                        else hg_m2_task(task - NT_RWS + BATCH * 8, C.lane, HG, hgS0, HGO, hgSp, hgSs);
                    }
                }
            } else if (p == 6) {
                for (int m = blockIdx.x * 2 + C.half; m < M; m += 2 * C.G)
                    m3_row(m, C.t256, HZ, RW, RK, RWO, HGO, in[22] + l * 256, in[23] + l * 256, in[25] + l * 512, OB);
            } else if (p == 7) {
                pg8::Gemm g{OB, (const bf16*)(wl + W_MO), M, D, D}; pg8::StaticOrder S; S.init(M, D, C.G, (int)blockIdx.x);
                pg8::EpiResidual E{X, D, ALPHA, 1.0f};
                pg8::gemm_phase<pg8::EpiResidual, pg8::StaticOrder, PG8_ALIGN, PG8_SP2>(C.lds + RING_OFF, g, S, E, C.tid);
            }
        }
        if (ph + 1 < hi) xcd_barrier(bar);
    }
}

extern "C" void kernel_launch(void* const* d_in, const int* in_sizes, int n_in, void* d_out, int out_size, void* d_ws, size_t ws_size, hipStream_t stream) {
    static int grid = 0;
    if (grid == 0) {
        if (n_in != 34 || ws_size < WS_END) { fprintf(stderr, "kernel_launch: unexpected n_in %d or ws_size %zu; nothing launched\n", n_in, ws_size); grid = -1; return; }
        int dev = 0, cus = 0, per_cu = 0;
        if (hipGetDevice(&dev) != hipSuccess || hipDeviceGetAttribute(&cus, hipDeviceAttributeMultiprocessorCount, dev) != hipSuccess) { grid = -1; return; }
        if (hipFuncSetAttribute((const void*)mk_fwd, hipFuncAttributeMaxDynamicSharedMemorySize, LDS_BYTES) != hipSuccess) { fprintf(stderr, "kernel_launch: hipFuncSetAttribute failed\n"); grid = -1; return; }
        if (hipOccupancyMaxActiveBlocksPerMultiprocessor(&per_cu, (const void*)mk_fwd, NWAVES * 64, LDS_BYTES) != hipSuccess || per_cu < 1) { fprintf(stderr, "kernel_launch: occupancy query reports %d workgroups per CU\n", per_cu); }
        (void)hipGetLastError();
        grid = cus;
        if (grid != 256) { fprintf(stderr, "kernel_launch: built for a 256-CU device (got %d CUs); nothing launched\n", cus); grid = -1; return; }
    }
    if (grid < 0) return;
    if (hipMemsetAsync((char*)d_ws + WS_CTL, 0, CTL_ZERO_BYTES, stream) != hipSuccess) return;
    Args a{};
    for (int i = 0; i < 34; ++i) a.in[i] = (const float*)d_in[i];
    a.out = (float*)d_out; a.ws = (unsigned char*)d_ws;
#if MK_SPLIT
    for (int ph = 0; ph < N_PHASES; ++ph) { a.ph_lo = ph; a.ph_hi = ph + 1; hipLaunchKernelGGL(mk_fwd, dim3(grid), dim3(NWAVES * 64), LDS_BYTES, stream, a); }
#else
    a.ph_lo = 0; a.ph_hi = N_PHASES;
    hipLaunchKernelGGL(mk_fwd, dim3(grid), dim3(NWAVES * 64), LDS_BYTES, stream, a);
#endif
}
```

```cpp
#include <hip/hip_runtime.h>
#include <cstdio>
#include <cstdint>
namespace pg8 {
#define PG8_LAS __attribute__((address_space(3)))
typedef unsigned short bf16_t;
typedef short bf16x8 __attribute__((ext_vector_type(8)));
typedef float f32x4 __attribute__((ext_vector_type(4)));
typedef unsigned u32x4 __attribute__((ext_vector_type(4)));
constexpr int BM = 256, BK = 64, HALF = 128, HTB = HALF * BK * 2  , STAGE_BYTES = 8 * HTB, NXCD = 8, WGM = 8;

__host__ __device__ __forceinline__ int lds_byte(int r, int c) { const int st = (r >> 4) * 2 + (c >> 5), rr = r & 15, cc = c & 31, ob = rr * 64 + cc * 2; return st * 1024 + (ob ^ (((ob >> 9) & 1) << 5)); }
__host__ __device__ __forceinline__ void stage_rc(int b, int& R, int& C) { const int st = b / 1024, sb = b % 1024, swz = sb ^ (((sb >> 9) & 1) << 5); R = (st >> 1) * 16 + swz / 64; C = (st & 1) * 32 + (swz % 64) / 2; }
__host__ __device__ __forceinline__ int perm32(int rho) { const int n = rho >> 4, i = rho & 15; return 8 * (i >> 2) + 4 * n + (i & 3); }

struct Unit { int pm, pn; };
struct Gemm { const bf16_t* A; const bf16_t* Bt; int M, N, K; };

struct StaticOrder {
    int nM, nN, nwg, G, c;
    __host__ __device__ void init(int M, int N, int G_, int c_) { nM = M / BM; nN = N / BM; nwg = nM * nN; G = G_; c = c_; }
    __host__ __device__ bool next(int i, Unit& u) const {
        const long L = (long)i * G + c; if (L >= nwg) return false;
        int wgid = (int)L; { const int q = nwg / NXCD, r = nwg % NXCD, xcd = wgid % NXCD, off = wgid / NXCD; wgid = (xcd < r ? xcd * (q + 1) : r * (q + 1) + (xcd - r) * q) + off; }
        const int nig = WGM * nN, gid = wgid / nig, fm = gid * WGM, gsz = (nM - fm) < WGM ? (nM - fm) : WGM;
        u.pm = fm + ((wgid % nig) % gsz); u.pn = (wgid % nig) / gsz; return true;
    }
    __device__ __forceinline__ void a_ready(const Unit&) const {}
    __device__ __forceinline__ void done(const Unit&) const {}
};
__device__ __forceinline__ unsigned cvt_pk_bf16(float lo, float hi) { unsigned r; asm volatile("v_cvt_pk_bf16_f32 %0, %1, %2" : "=v"(r) : "v"(lo), "v"(hi)); return r; }
__device__ __forceinline__ float silu_f(float x) { return x * __builtin_amdgcn_rcpf(1.0f + __expf(-x)); }
struct EpiSwiGLU {
    static constexpr bool PERM = true, AFTER_DRAIN = false;
    bf16_t* O; int ldc;
    __device__ __forceinline__ void operator()(const f32x4 (&acc)[2][2][4][2], const Unit& u, int wr, int wc, int fr, int fq) const {
        const int row0 = u.pm * BM + wr * 64 + fr, col0 = u.pn * HALF + wc * 32 + 8 * fq;
#pragma unroll
        for (int ai = 0; ai < 2; ++ai)
#pragma unroll
            for (int m = 0; m < 4; ++m) { bf16_t* rowp = O + (size_t)(row0 + ai * HALF + m * 16) * ldc + col0;
                const f32x4 g0 = acc[ai][0][m][0], g1 = acc[ai][0][m][1], u0 = acc[ai][1][m][0], u1 = acc[ai][1][m][1];
                u32x4 w; w.x = cvt_pk_bf16(silu_f(g0[0]) * u0[0], silu_f(g0[1]) * u0[1]); w.y = cvt_pk_bf16(silu_f(g0[2]) * u0[2], silu_f(g0[3]) * u0[3]);
                w.z = cvt_pk_bf16(silu_f(g1[0]) * u1[0], silu_f(g1[1]) * u1[1]); w.w = cvt_pk_bf16(silu_f(g1[2]) * u1[2], silu_f(g1[3]) * u1[3]);
                *(u32x4*)rowp = w; }
    }
};
struct EpiStoreBf16 {
    static constexpr bool PERM = true, AFTER_DRAIN = false;
    bf16_t* O; int ldc;
    __device__ __forceinline__ void operator()(const f32x4 (&acc)[2][2][4][2], const Unit& u, int wr, int wc, int fr, int fq) const {
        const int row0 = u.pm * BM + wr * 64 + fr, col0 = u.pn * BM + wc * 32 + 8 * fq;
#pragma unroll
        for (int ai = 0; ai < 2; ++ai)
#pragma unroll
            for (int m = 0; m < 4; ++m) { bf16_t* rowp = O + (size_t)(row0 + ai * HALF + m * 16) * ldc + col0;
#pragma unroll
                for (int bj = 0; bj < 2; ++bj) { const f32x4 v0 = acc[ai][bj][m][0], v1 = acc[ai][bj][m][1];
                    u32x4 w; w.x = cvt_pk_bf16(v0[0], v0[1]); w.y = cvt_pk_bf16(v0[2], v0[3]); w.z = cvt_pk_bf16(v1[0], v1[1]); w.w = cvt_pk_bf16(v1[2], v1[3]);
                    *(u32x4*)(rowp + bj * HALF) = w; } }
    }
};
struct EpiResidual {
    static constexpr bool PERM = false, AFTER_DRAIN = false;
    float* X; int ldc; float alpha, scale;
    __device__ __forceinline__ void operator()(const f32x4 (&acc)[2][2][4][2], const Unit& u, int wr, int wc, int fr, int fq) const {
        const int row0 = u.pm * BM + wr * 64 + fr, col0 = u.pn * BM + wc * 32 + 4 * fq;
#pragma unroll
        for (int ai = 0; ai < 2; ++ai)
#pragma unroll
            for (int m = 0; m < 4; ++m) { float* rowp = X + (size_t)(row0 + ai * HALF + m * 16) * ldc + col0;
                f32x4 xv[2][2];
#pragma unroll
                for (int bj = 0; bj < 2; ++bj)
#pragma unroll
                    for (int n = 0; n < 2; ++n) xv[bj][n] = *(const f32x4*)(rowp + bj * HALF + n * 16);
#pragma unroll
                for (int bj = 0; bj < 2; ++bj)
#pragma unroll
                    for (int n = 0; n < 2; ++n) *(f32x4*)(rowp + bj * HALF + n * 16) = xv[bj][n] * alpha + acc[ai][bj][m][n] * scale;
                asm volatile("" ::: "memory"); }
    }
};
template <class Epi, class Sched, bool ALIGN_EPI = false, bool SP2 = false>
__device__ __forceinline__ void gemm_phase(PG8_LAS unsigned char* lds, const Gemm g, const Sched& S, const Epi& E, const int tid) {
    const int wid = __builtin_amdgcn_readfirstlane(tid >> 6), lane = tid & 63, wr = wid >> 2, wc = wid & 3, fr = lane & 15, fq = lane >> 4;
    const int K = g.K, nt = K / BK;
    unsigned voffA[2], voffB[2];
#pragma unroll
    for (int i = 0; i < 2; ++i) { int R, C; stage_rc(tid * 16 + i * 8192, R, C); const int Rb = Epi::PERM ? ((R & ~31) + perm32(R & 31)) : R;
        voffA[i] = (unsigned)(R * K + C) * 2u; voffB[i] = (unsigned)(Rb * K + C) * 2u; }
    const size_t kstep = (size_t)(BK * 2);
    const size_t hstep = (size_t)HALF * K * 2;
    const size_t tstep = 2 * hstep;
    const unsigned ldsw = (unsigned)wid * 1024u;
    const int aoff = lds_byte(wr * 64 + fr, fq * 8), boff = lds_byte(wc * 32 + fr, fq * 8);
#define PG8_SA(b, h) (((b) * 2 + (h)) * HTB)
#define PG8_SB(b, h) ((4 + (b) * 2 + (h)) * HTB)
#define PG8_STAGE(bufoff, gbase, voff) do { _Pragma("unroll") for (int _i = 0; _i < 2; ++_i) \
        __builtin_amdgcn_global_load_lds((const unsigned*)((const char*)(gbase) + (voff)[_i]), (PG8_LAS unsigned*)(lds + (bufoff) + ldsw + _i * 8192), 16, 0, 0); } while (0)
#define PG8_LDA(dst, b, h) do { _Pragma("unroll") for (int m = 0; m < 4; ++m) _Pragma("unroll") for (int k = 0; k < 2; ++k) dst[m][k] = *(const PG8_LAS bf16x8*)(lds + PG8_SA(b, h) + aoff + m * 2048 + k * 1024); } while (0)
#define PG8_LDB(dst, b, h) do { _Pragma("unroll") for (int n = 0; n < 2; ++n) _Pragma("unroll") for (int k = 0; k < 2; ++k) dst[n][k] = *(const PG8_LAS bf16x8*)(lds + PG8_SB(b, h) + boff + n * 2048 + k * 1024); } while (0)
#define PG8_MMA(ai, bj, At, Bt) do { __builtin_amdgcn_s_setprio(1); _Pragma("unroll") for (int m = 0; m < 4; ++m) _Pragma("unroll") for (int n = 0; n < 2; ++n) _Pragma("unroll") for (int k = 0; k < 2; ++k) \
        acc[ai][bj][m][n] = __builtin_amdgcn_mfma_f32_16x16x32_bf16(Bt[n][k], At[m][k], acc[ai][bj][m][n], 0, 0, 0); __builtin_amdgcn_s_setprio(0); } while (0)
#define PG8_WAIT_V(n) asm volatile("s_waitcnt vmcnt(" #n ")" ::: "memory")
#define PG8_WAIT_L(n) asm volatile("s_waitcnt lgkmcnt(" #n ")" ::: "memory")
#define PG8_BAR __builtin_amdgcn_s_barrier()
#define PG8_SCHED __builtin_amdgcn_sched_barrier(0)
    Unit cur, nxt; int ui = 0;
    if (!S.next(0, cur)) return;
    f32x4 acc[2][2][4][2];
#pragma unroll
    for (int a = 0; a < 2; ++a)
#pragma unroll
        for (int b = 0; b < 2; ++b)
#pragma unroll
            for (int m = 0; m < 4; ++m)
#pragma unroll
                for (int n = 0; n < 2; ++n) acc[a][b][m][n] = (f32x4){0.f, 0.f, 0.f, 0.f};
    bf16x8 At[4][2], B0[2][2], B1[2][2];
    const char* cA = (const char*)g.A + (size_t)cur.pm * tstep; const char* cB = (const char*)g.Bt + (size_t)cur.pn * tstep;
    S.a_ready(cur);
    if constexpr (SP2) {
        PG8_STAGE(PG8_SB(0, 0), cB, voffB); PG8_STAGE(PG8_SB(0, 1), cB + hstep, voffB); PG8_STAGE(PG8_SA(0, 0), cA, voffA); PG8_STAGE(PG8_SA(0, 1), cA + hstep, voffA);
        if (wr == 1) PG8_BAR;
        PG8_WAIT_V(2); PG8_BAR;
        PG8_STAGE(PG8_SB(1, 0), cB + kstep, voffB); PG8_STAGE(PG8_SA(1, 0), cA + kstep, voffA); PG8_STAGE(PG8_SB(1, 1), cB + hstep + kstep, voffB);
        PG8_WAIT_V(6); PG8_BAR;
    } else {
        PG8_STAGE(PG8_SB(0, 0), cB, voffB); PG8_STAGE(PG8_SA(0, 0), cA, voffA); PG8_STAGE(PG8_SB(0, 1), cB + hstep, voffB); PG8_STAGE(PG8_SA(0, 1), cA + hstep, voffA);
        if (wr == 1) PG8_BAR;
        PG8_WAIT_V(4); PG8_BAR;
        PG8_STAGE(PG8_SB(1, 0), cB + kstep, voffB); PG8_STAGE(PG8_SA(1, 0), cA + kstep, voffA); PG8_STAGE(PG8_SB(1, 1), cB + hstep + kstep, voffB);
        PG8_WAIT_V(6); PG8_BAR;
    }
    for (;;) {
        const bool has_next = S.next(ui + 1, nxt);
        const char* nA = has_next ? (const char*)g.A + (size_t)nxt.pm * tstep : cA; const char* nB = has_next ? (const char*)g.Bt + (size_t)nxt.pn * tstep : cB;
        for (int t = 0; t < nt; t += 2) {
            const bool last = (t == nt - 2);
            const char* a1 = cA + (size_t)(t + 1) * kstep;
            const char* a2 = last ? nA : cA + (size_t)(t + 2) * kstep; const char* b2 = last ? nB : cB + (size_t)(t + 2) * kstep;
            const char* a3 = a2 + kstep; const char* b3 = b2 + kstep;
            if (last && has_next) S.a_ready(nxt);
            if constexpr (SP2) {
            PG8_LDB(B0, 0, 0); PG8_LDB(B1, 0, 1); PG8_SCHED; PG8_LDA(At, 0, 0); PG8_STAGE(PG8_SA(1, 1), a1 + hstep, voffA);
            PG8_WAIT_V(8); PG8_WAIT_L(0); PG8_BAR; PG8_MMA(0, 0, At, B0); PG8_MMA(0, 1, At, B1); PG8_BAR; PG8_SCHED;
            PG8_LDA(At, 0, 1); PG8_STAGE(PG8_SB(0, 0), b2, voffB); PG8_STAGE(PG8_SB(0, 1), b2 + hstep, voffB); PG8_STAGE(PG8_SA(0, 0), a2, voffA);
            PG8_WAIT_V(8); PG8_WAIT_L(0); PG8_BAR; PG8_MMA(1, 0, At, B0); PG8_MMA(1, 1, At, B1); PG8_BAR; PG8_SCHED;
            PG8_LDB(B0, 1, 0); PG8_LDB(B1, 1, 1); PG8_SCHED; PG8_LDA(At, 1, 0); PG8_STAGE(PG8_SA(0, 1), a2 + hstep, voffA);
            PG8_WAIT_V(8); PG8_WAIT_L(0); PG8_BAR; PG8_MMA(0, 0, At, B0); PG8_MMA(0, 1, At, B1); PG8_BAR; PG8_SCHED;
            PG8_LDA(At, 1, 1); PG8_STAGE(PG8_SB(1, 0), b3, voffB); PG8_STAGE(PG8_SB(1, 1), b3 + hstep, voffB); PG8_STAGE(PG8_SA(1, 0), a3, voffA);
            PG8_WAIT_V(8); PG8_WAIT_L(0); PG8_BAR; PG8_MMA(1, 0, At, B0); PG8_MMA(1, 1, At, B1); PG8_BAR; PG8_SCHED;
            } else {
            PG8_LDB(B0, 0, 0); PG8_SCHED; PG8_LDA(At, 0, 0); PG8_STAGE(PG8_SA(1, 1), a1 + hstep, voffA);
            PG8_WAIT_L(8); PG8_BAR; PG8_WAIT_L(0); PG8_MMA(0, 0, At, B0); PG8_BAR; PG8_SCHED;
            PG8_LDB(B1, 0, 1); PG8_STAGE(PG8_SB(0, 0), b2, voffB);
            PG8_BAR; PG8_WAIT_L(0); PG8_MMA(0, 1, At, B1); PG8_BAR;
            PG8_LDA(At, 0, 1); PG8_STAGE(PG8_SA(0, 0), a2, voffA);
            PG8_BAR; PG8_WAIT_L(0); PG8_MMA(1, 0, At, B0); PG8_BAR; PG8_SCHED;
            PG8_STAGE(PG8_SB(0, 1), b2 + hstep, voffB);
            PG8_WAIT_V(6); PG8_BAR; PG8_MMA(1, 1, At, B1); PG8_BAR;
            PG8_LDB(B0, 1, 0); PG8_SCHED; PG8_LDA(At, 1, 0); PG8_STAGE(PG8_SA(0, 1), a2 + hstep, voffA);
            PG8_WAIT_L(8); PG8_BAR; PG8_WAIT_L(0); PG8_MMA(0, 0, At, B0); PG8_BAR; PG8_SCHED;
            PG8_LDB(B1, 1, 1); PG8_STAGE(PG8_SB(1, 0), b3, voffB);
            PG8_BAR; PG8_WAIT_L(0); PG8_MMA(0, 1, At, B1); PG8_BAR;
            PG8_LDA(At, 1, 1); PG8_STAGE(PG8_SA(1, 0), a3, voffA);
            PG8_BAR; PG8_WAIT_L(0); PG8_MMA(1, 0, At, B0); PG8_BAR; PG8_SCHED;
            PG8_STAGE(PG8_SB(1, 1), b3 + hstep, voffB);
            PG8_WAIT_V(6); PG8_BAR; PG8_MMA(1, 1, At, B1); PG8_BAR;
            }
        }
        if constexpr (ALIGN_EPI) { if (wr == 0) PG8_BAR; }
        if constexpr (!Epi::AFTER_DRAIN) { E(acc, cur, wr, wc, fr, fq); S.done(cur); }
        if (!has_next) break;
#pragma unroll
        for (int a = 0; a < 2; ++a)
#pragma unroll
            for (int b = 0; b < 2; ++b)
#pragma unroll
                for (int m = 0; m < 4; ++m)
#pragma unroll
                    for (int n = 0; n < 2; ++n) acc[a][b][m][n] = (f32x4){0.f, 0.f, 0.f, 0.f};
        cur = nxt; cA = nA; cB = nB; ++ui;
        if constexpr (ALIGN_EPI) { if (wr == 1) PG8_BAR; }
    }
    PG8_WAIT_V(0);
    if constexpr (!ALIGN_EPI) { if (wr == 0) PG8_BAR; }
    PG8_BAR;
    if constexpr (Epi::AFTER_DRAIN) { E.fused(acc, cur, wr, wc, fr, fq, lds, wid, lane); S.done(cur); }
#undef PG8_SA
#undef PG8_SB
#undef PG8_STAGE
#undef PG8_LDA
#undef PG8_LDB
#undef PG8_MMA
#undef PG8_WAIT_V
#undef PG8_WAIT_L
#undef PG8_BAR
#undef PG8_SCHED
}
}

#define GAS __attribute__((address_space(1)))
#define LAS __attribute__((address_space(3)))
typedef unsigned short bf16;
typedef unsigned v4u __attribute__((ext_vector_type(4)));
typedef float f32x4 __attribute__((ext_vector_type(4)));
typedef short bf16x8 __attribute__((ext_vector_type(8)));
typedef GAS unsigned gu32;
#define RLX_AGENT __ATOMIC_RELAXED, __HIP_MEMORY_SCOPE_AGENT
#define LDS_WAIT() asm volatile("s_waitcnt lgkmcnt(0)" ::: "memory")
#define VM_WAIT() asm volatile("s_waitcnt vmcnt(0)" ::: "memory")
__device__ __forceinline__ unsigned pk2(float lo, float hi) { unsigned r; asm("v_cvt_pk_bf16_f32 %0, %1, %2" : "=v"(r) : "v"(lo), "v"(hi)); return r; }
__device__ __forceinline__ unsigned f2bf(float f) { return pk2(f, 0.f) & 0xffffu; }
__device__ __forceinline__ float bf2f(bf16 b) { return __uint_as_float(((unsigned)b) << 16); }

#define XB_TMO      128
#define XB_XCNT(j)  (256  + 64 * (j))
#define XB_XSUB(j)  (1280 + 64 * (j))
#define XB_XGEN(j)  (2304 + 64 * (j))
#define XB_TOP      3328
#define XB_TOPGEN   3392
#define XCD_BAR_WORDS 3456
#define XB_SPIN_CAP (1u << 18)

__device__ __forceinline__ unsigned xb_ld(unsigned* p)              { return __hip_atomic_load(p, __ATOMIC_RELAXED, __HIP_MEMORY_SCOPE_AGENT); }
__device__ __forceinline__ unsigned xb_add(unsigned* p, unsigned v) { return __hip_atomic_fetch_add(p, v, __ATOMIC_RELAXED, __HIP_MEMORY_SCOPE_AGENT); }
__device__ __forceinline__ unsigned xb_xcc_id() { return (unsigned)__builtin_amdgcn_s_getreg((3 << 11) | 20) & 0xFu; }
#define XB_SPIN(cond, bar) do { unsigned _sp = 0; while (cond) { __builtin_amdgcn_s_sleep(1); \
    if ((++_sp & 255u) == 0u) { if (xb_ld(&(bar)[XB_TMO])) break; if (_sp > XB_SPIN_CAP) { atomicAdd(&(bar)[XB_TMO], 1u); break; } } } } while (0)

struct XcdBarrier {
    unsigned* bar; unsigned x;
    volatile LAS unsigned* st;
};

__device__ __forceinline__ XcdBarrier xcd_barrier_post(unsigned* bar, volatile LAS unsigned* st) {
    XcdBarrier b; b.bar = bar; b.x = xb_xcc_id(); b.st = st;
    if (threadIdx.x == 0) (void)xb_add(&bar[XB_XCNT(b.x)], 1u);
    return b;
}
__device__ __forceinline__ void xcd_barrier_complete(unsigned* bar, unsigned x, unsigned& nloc, unsigned& nx) {
    const unsigned G = gridDim.x * gridDim.y * gridDim.z;
    unsigned sum, cnt, mine, sp = 0u;
    for (;;) {
        sum = 0u; cnt = 0u; mine = 0u;
#pragma unroll
        for (unsigned j = 0; j < 16; ++j) { const unsigned c = xb_ld(&bar[XB_XCNT(j)]); sum += c; cnt += (c > 0u) ? 1u : 0u; mine = (j == x) ? c : mine; }
        if (sum == G) break;
        __builtin_amdgcn_s_sleep(1);
        if ((++sp & 255u) == 0u) { if (xb_ld(&bar[XB_TMO])) break; if (sp > XB_SPIN_CAP) { atomicAdd(&bar[XB_TMO], 1u); break; } }
    }
    nloc = mine > 0u ? mine : 1u; nx = cnt > 0u ? cnt : 1u;
}

__device__ __forceinline__ void xcd_barrier(const XcdBarrier& b) {
    asm volatile("s_waitcnt vmcnt(0)" ::: "memory");
    __syncthreads();
    if (threadIdx.x == 0) {
        unsigned* bar = b.bar;
        __builtin_amdgcn_s_waitcnt(0);
        unsigned nloc = b.st[0], nx = b.st[1];
        if (nloc == 0u) { xcd_barrier_complete(bar, b.x, nloc, nx); b.st[0] = nloc; b.st[1] = nx; }
        const unsigned old = xb_add(&bar[XB_XSUB(b.x)], 1u);
        const unsigned gen = old / nloc;
        if (old + 1u == (gen + 1u) * nloc) {
            __builtin_amdgcn_fence(__ATOMIC_RELEASE, "agent");
            asm volatile("s_waitcnt vmcnt(0)" ::: "memory");
            const unsigned og = xb_add(&bar[XB_TOP], 1u);
            const unsigned tg = og / nx;
            if (og + 1u == (tg + 1u) * nx) xb_add(&bar[XB_TOPGEN], 1u);
            else XB_SPIN(xb_ld(&bar[XB_TOPGEN]) == tg, bar);
            __builtin_amdgcn_fence(__ATOMIC_ACQUIRE, "agent");
            xb_add(&bar[XB_XGEN(b.x)], 1u);
            asm volatile("s_waitcnt vmcnt(0)" ::: "memory");
        } else {
            XB_SPIN(xb_ld(&bar[XB_XGEN(b.x)]) == gen, bar);
            __builtin_amdgcn_fence(__ATOMIC_ACQUIRE, "agent");
            asm volatile("s_waitcnt vmcnt(0)" ::: "memory");
        }
    }
    __syncthreads();
}

#ifndef PG8_SP2
#define PG8_SP2 true
#endif
#ifndef PG8_ALIGN
#define PG8_ALIGN true
#endif
#ifndef PROBE_KIND
#define PROBE_KIND -1
#endif
#ifndef PROBE_SUB
#define PROBE_SUB 0xFF
#endif
#ifndef MK_SPLIT
#define MK_SPLIT 0
#endif

constexpr int NWAVES = 8;
constexpr int D = 1024, BATCH = 8, SEQ = 2048, DEPTH = 2, DB = 128, DS = 4;
constexpr int MP = BATCH * SEQ, MS = DB * DS, M = MP + MS;
constexpr int DFF = 2816, NIN = 3584;
constexpr float ALPHA = 1.41421356237309515f;
constexpr size_t O_Y = 0, O_RWSP = 17301504, O_RWSHP = 17563648, O_HGSP = 17580032, O_RWSS = 18628608, O_RWSHS = 22822912, O_HGSS = 23085056, O_CMV = 39862272;
constexpr size_t MiB = 1u << 20;
constexpr size_t WS_CTL = 0, CTL_ZERO_BYTES = 1 * MiB;
constexpr size_t WS_W = 2 * MiB;
constexpr size_t W_1IN = 0, W_1OUT = 11 * MiB, W_MI = 17 * MiB, W_MO = 24 * MiB, W_2IN = 26 * MiB, W_2OUT = 37 * MiB, W_LAYER = 43 * MiB;
constexpr size_t WS_LW = 88 * MiB;
constexpr size_t LW_W = 0, LW_A = 32768, LW_G = 65536, LW_CM = 131072, LW_LAYER = 262144;
constexpr size_t WS_XB = 90 * MiB;
constexpr size_t WS_OB = 124 * MiB;
constexpr size_t WS_HZ = 158 * MiB;
constexpr size_t WS_RW = 276 * MiB;
constexpr size_t WS_RK = 392 * MiB;
constexpr size_t WS_HG = 393 * MiB;
constexpr size_t WS_QP = 397 * MiB;
constexpr size_t WS_KT = 413 * MiB;
constexpr size_t WS_VT = 429 * MiB;
constexpr size_t WS_DD = 445 * MiB;
constexpr size_t WS_AA = 447 * MiB;
constexpr size_t WS_RWO = 493 * MiB;
constexpr size_t WS_HGO = 510 * MiB;
constexpr size_t WS_END = 544 * MiB;
constexpr int CW_TMO = 0, CW_CODE = 1, CW_BAR = 4096;
constexpr int RING_OFF = 0, RING_BYTES = 131072;
constexpr int LDSCTL_OFF = 135168, MISC_OFF = LDSCTL_OFF + 320;
constexpr int LDS_BYTES = 147456;

struct Ctx { LAS unsigned char* lds; int tid, lane, wave, half, t256, G, gw, NGW; };

__device__ __forceinline__ float wave_sum(float v) {
#pragma unroll
    for (int o = 1; o < 64; o <<= 1) v += __shfl_xor(v, o);
    return v;
}
__device__ __forceinline__ float sigmoidf_(float x) { return 1.0f / (1.0f + expf(-x)); }
__device__ __forceinline__ float siluf_(float x) { return x / (1.0f + expf(-x)); }
__device__ __forceinline__ float geluf_(float x) { return 0.5f * x * (1.0f + erff(x * 0.70710678118654752f)); }
__device__ __forceinline__ float softplusf_(float x) { return x > 20.0f ? x : log1pf(expf(x)); }
__device__ __forceinline__ void row_info(int m, int& b, int& t, int& T, bool& smp) {
    if (m < MP) { smp = false; b = m / SEQ; t = m % SEQ; T = SEQ; } else { smp = true; b = (m - MP) / DS; t = (m - MP) % DS; T = DS; }
}

__device__ __forceinline__ void p0_transpose_item(const float* W, int K, int N, bf16* WT, int interleave, LAS float* scr, int item, int lane) {
    const int nblk = N / 32, kb = item / nblk, nb = item % nblk, k0 = 64 * kb, n0 = 32 * nb;
    int row0 = n0;
    if (interleave) { const int half = N / 2; const int j0 = n0 < half ? n0 : n0 - half; row0 = 256 * (j0 / 128) + (j0 % 128) + (n0 < half ? 0 : 128); }
#pragma unroll 8
    for (int i = 0; i < 32; ++i) { const int kk = 2 * i + (lane >> 5); scr[kk * 33 + (lane & 31)] = W[(size_t)(k0 + kk) * N + n0 + (lane & 31)]; }
    LDS_WAIT(); asm volatile("" ::: "memory");
    const int c = lane & 7;
#pragma unroll
    for (int j = 0; j < 4; ++j) { const int n = (lane >> 3) + 8 * j; const LAS float* s = scr + (8 * c) * 33 + n;
        v4u o; o.x = pk2(s[0 * 33], s[1 * 33]); o.y = pk2(s[2 * 33], s[3 * 33]); o.z = pk2(s[4 * 33], s[5 * 33]); o.w = pk2(s[6 * 33], s[7 * 33]);
        *(GAS v4u*)(WT + (size_t)(row0 + n) * K + k0 + 8 * c) = o; }
    LDS_WAIT(); asm volatile("" ::: "memory");
}
__device__ __forceinline__ void phase_prologue(const Ctx& C, const float* const* in, unsigned char* ws, float* X, bf16* XB) {
    LAS float* scr = (LAS float*)(C.lds + RING_OFF + C.wave * 16384);
    constexpr int I_IN = (D / 64) * (2 * DFF / 32), I_OUT = (DFF / 64) * (D / 32), I_MI = (D / 64) * (NIN / 32), I_MO = (D / 64) * (D / 32);
    constexpr int I_LAYER = 2 * I_IN + 2 * I_OUT + I_MI + I_MO;
    for (int it = C.gw; it < DEPTH * I_LAYER; it += C.NGW) {
        const int l = it / I_LAYER; int r = it % I_LAYER;
        bf16* wl = (bf16*)(ws + WS_W + (size_t)l * W_LAYER);
        if (r < I_IN) { p0_transpose_item(in[5] + (size_t)l * D * 2 * DFF, D, 2 * DFF, (bf16*)((char*)wl + W_1IN), 1, scr, r, C.lane); continue; } r -= I_IN;
        if (r < I_OUT) { p0_transpose_item(in[6] + (size_t)l * DFF * D, DFF, D, (bf16*)((char*)wl + W_1OUT), 0, scr, r, C.lane); continue; } r -= I_OUT;
        if (r < I_MI) { p0_transpose_item(in[9] + (size_t)l * D * NIN, D, NIN, (bf16*)((char*)wl + W_MI), 0, scr, r, C.lane); continue; } r -= I_MI;
        if (r < I_MO) { p0_transpose_item(in[10] + (size_t)l * D * D, D, D, (bf16*)((char*)wl + W_MO), 0, scr, r, C.lane); continue; } r -= I_MO;
        if (r < I_IN) { p0_transpose_item(in[30] + (size_t)l * D * 2 * DFF, D, 2 * DFF, (bf16*)((char*)wl + W_2IN), 1, scr, r, C.lane); continue; } r -= I_IN;
        p0_transpose_item(in[31] + (size_t)l * DFF * D, DFF, D, (bf16*)((char*)wl + W_2OUT), 0, scr, r, C.lane);
    }
    for (int i = blockIdx.x * 512 + C.tid; i < DEPTH * 131072; i += C.G * 512) {
        const int l = i >> 17, e = i & 131071; bf16* lw = (bf16*)(ws + WS_LW + (size_t)l * LW_LAYER);
        if (e < 16384) { const int n = e >> 6, k = e & 63; lw[LW_W / 2 + e] = (bf16)f2bf(in[15][(size_t)l * 16384 + k * 256 + n]); }
        else if (e < 32768) { const int e2 = e - 16384, n = e2 >> 6, k = e2 & 63; lw[LW_A / 2 + e2] = (bf16)f2bf(in[17][(size_t)l * 16384 + k * 256 + n]); }
        else if (e < 65536) { const int e2 = e - 32768, n = e2 >> 7, k = e2 & 127; lw[LW_G / 2 + e2] = (bf16)f2bf(in[18][(size_t)l * 32768 + k * 256 + n]); }
        else { const int e2 = e - 65536, t = (e2 >> 7) & 127, s = e2 & 127; lw[LW_CM / 2 + e2] = (bf16)f2bf(s <= t ? in[26][(size_t)l * 65536 + e2] : 0.f); }
    }
    const size_t n4 = (size_t)M * D / 4, np4 = (size_t)MP * D / 4;
    for (size_t i = (size_t)blockIdx.x * 512 + C.tid; i < n4; i += (size_t)C.G * 512) {
        const f32x4 v = i < np4 ? ((const f32x4*)in[0])[i] : ((const f32x4*)in[1])[i - np4];
        ((f32x4*)X)[i] = v;
        ((unsigned long long*)XB)[i] = (unsigned long long)pk2(v.x, v.y) | ((unsigned long long)pk2(v.z, v.w) << 32);
    }
}

__device__ __forceinline__ void phase_ln(const Ctx& C, float* X, bf16* XB, const float* g, const float* b) {
    for (int row = C.gw; row < M; row += C.NGW) {
        f32x4* xr = (f32x4*)(X + (size_t)row * D) + C.lane;
        f32x4 v[4]; float s = 0.f;
#pragma unroll
        for (int j = 0; j < 4; ++j) { v[j] = xr[64 * j]; s += (v[j].x + v[j].y) + (v[j].z + v[j].w); }
        const float mean = wave_sum(s) * (1.f / D); float s2 = 0.f;
#pragma unroll
        for (int j = 0; j < 4; ++j) { v[j] = v[j] - mean; s2 += (v[j].x * v[j].x + v[j].y * v[j].y) + (v[j].z * v[j].z + v[j].w * v[j].w); }
        const float rstd = rsqrtf(wave_sum(s2) * (1.f / D) + 1e-5f);
#pragma unroll
        for (int j = 0; j < 4; ++j) {
            const f32x4 gg = ((const f32x4*)g)[C.lane + 64 * j], bb = ((const f32x4*)b)[C.lane + 64 * j];
            const f32x4 o = v[j] * rstd * gg + bb;
            xr[64 * j] = o;
            ((unsigned long long*)(XB + (size_t)row * D))[C.lane + 64 * j] = (unsigned long long)pk2(o.x, o.y) | ((unsigned long long)pk2(o.z, o.w) << 32);
        }
    }
}

struct RwParams { const float *mu, *w0, *w_w2, *a0, *a_w2, *g_w2, *k_k, *k_a, *r_k; };
__device__ __forceinline__ float dpp_sum16(float x) {
    x += __builtin_bit_cast(float, __builtin_amdgcn_update_dpp(0, __builtin_bit_cast(int, x), 0xB1, 0xF, 0xF, true));
    x += __builtin_bit_cast(float, __builtin_amdgcn_update_dpp(0, __builtin_bit_cast(int, x), 0x4E, 0xF, 0xF, true));
    x += __builtin_bit_cast(float, __builtin_amdgcn_update_dpp(0, __builtin_bit_cast(int, x), 0x141, 0xF, 0xF, true));
    x += __builtin_bit_cast(float, __builtin_amdgcn_update_dpp(0, __builtin_bit_cast(int, x), 0x140, 0xF, 0xF, true));
    return x;
}
__device__ __forceinline__ void rw_m1_pair(const Ctx& C, int pair, const bf16* z, const float* shift_s, const RwParams& P, const bf16* LW, float* ops, float* rk, float* sh_p, float* sh_s) {
    constexpr int ZS = 1028;
    LAS float* zs = (LAS float*)(C.lds + C.half * (16 * ZS * 4));
    const int tid = C.t256, m0 = (2 * pair + C.half) * 16, lane = C.lane, h = tid >> 6, g = lane >> 4, fr = lane & 15;
    {
        const int c = 4 * tid;
        uint2 zr[17];
#pragma unroll
        for (int i = 0; i < 17; ++i) { const int m = m0 - 1 + i; zr[i] = (m >= 0) ? *(const uint2*)(z + (size_t)m * NIN + c) : (uint2){0u, 0u}; }
        const f32x4 mu = *(const f32x4*)(P.mu + c);
#pragma unroll
        for (int i = 0; i < 16; ++i) {
            const int m = m0 + i; int b, t, T; bool smp; row_info(m, b, t, T, smp);
            const f32x4 zc = {__uint_as_float(zr[i + 1].x << 16), __uint_as_float(zr[i + 1].x & 0xffff0000u), __uint_as_float(zr[i + 1].y << 16), __uint_as_float(zr[i + 1].y & 0xffff0000u)};
            f32x4 zp = {__uint_as_float(zr[i].x << 16), __uint_as_float(zr[i].x & 0xffff0000u), __uint_as_float(zr[i].y << 16), __uint_as_float(zr[i].y & 0xffff0000u)};
            if (t == 0) zp = smp ? *(const f32x4*)(shift_s + (size_t)b * 1024 + c) : (f32x4){0.f, 0.f, 0.f, 0.f};
            f32x4 v = zc + (zp - zc) * mu;
            if (c >= 768 && c < 832) { v.x = tanhf(v.x); v.y = tanhf(v.y); v.z = tanhf(v.z); v.w = tanhf(v.w); }
            if (c >= 896) { v.x = sigmoidf_(v.x); v.y = sigmoidf_(v.y); v.z = sigmoidf_(v.z); v.w = sigmoidf_(v.w); }
            *(LAS f32x4*)(zs + i * ZS + c) = v;
            if (t == T - 1) *(f32x4*)((smp ? sh_s : sh_p) + (size_t)b * 1024 + c) = zc;
        }
    }
    __syncthreads();
    f32x4 aw[4], aa[4], ag[4];
#pragma unroll
    for (int nt = 0; nt < 4; ++nt) { aw[nt] = (f32x4){0.f, 0.f, 0.f, 0.f}; aa[nt] = aw[nt]; ag[nt] = aw[nt]; }
#pragma unroll
    for (int ks = 0; ks < 8; ++ks) {
        const LAS float* ap = zs + fr * ZS + 768 + 32 * ks + 8 * g;
        const f32x4 x0 = *(const LAS f32x4*)ap, x1 = *(const LAS f32x4*)(ap + 4);
        v4u au; au.x = pk2(x0.x, x0.y); au.y = pk2(x0.z, x0.w); au.z = pk2(x1.x, x1.y); au.w = pk2(x1.z, x1.w);
        const bf16x8 af = __builtin_bit_cast(bf16x8, au);
#pragma unroll
        for (int nt = 0; nt < 4; ++nt) {
            const int n = 64 * h + 16 * nt + fr;
            if (ks < 2) { const bf16x8 bfr = *(const bf16x8*)(LW + LW_W / 2 + (size_t)n * 64 + 32 * ks + 8 * g); aw[nt] = __builtin_amdgcn_mfma_f32_16x16x32_bf16(af, bfr, aw[nt], 0, 0, 0); }
            else if (ks < 4) { const bf16x8 bfr = *(const bf16x8*)(LW + LW_A / 2 + (size_t)n * 64 + 32 * (ks - 2) + 8 * g); aa[nt] = __builtin_amdgcn_mfma_f32_16x16x32_bf16(af, bfr, aa[nt], 0, 0, 0); }
            else { const bf16x8 bfr = *(const bf16x8*)(LW + LW_G / 2 + (size_t)n * 128 + 32 * (ks - 4) + 8 * g); ag[nt] = __builtin_amdgcn_mfma_f32_16x16x32_bf16(af, bfr, ag[nt], 0, 0, 0); }
        }
    }
    float ss[4] = {0.f, 0.f, 0.f, 0.f};
#pragma unroll
    for (int nt = 0; nt < 4; ++nt) { const int c = 64 * h + 16 * nt + fr; const float kkc = P.k_k[c];
#pragma unroll
        for (int r = 0; r < 4; ++r) { const float kk = zs[(4 * g + r) * ZS + 256 + c] * kkc; ss[r] += kk * kk; } }
    float inv[4], rks[4] = {0.f, 0.f, 0.f, 0.f};
#pragma unroll
    for (int r = 0; r < 4; ++r) inv[r] = 1.0f / fmaxf(sqrtf(dpp_sum16(ss[r])), 1e-12f);
#pragma unroll
    for (int nt = 0; nt < 4; ++nt) {
        const int c = 64 * h + 16 * nt + fr;
        const float w0 = P.w0[c], a0 = P.a0[c], kkc = P.k_k[c], kac = P.k_a[c], rkc = P.r_k[c];
#pragma unroll
        for (int r = 0; r < 4; ++r) {
            const int t = 4 * g + r;
            const float rr = zs[t * ZS + c], k = zs[t * ZS + 256 + c], v = zs[t * ZS + 512 + c];
            const float wlog = -softplusf_(-(w0 + aw[nt][r])) - 0.5f;
            const float decay = expf(-expf(wlog));
            const float a = sigmoidf_(a0 + aa[nt][r]);
            const float kk = k * kkc * inv[r];
            const float k2 = k * (1.0f + (a - 1.0f) * kac);
            rks[r] += rr * k2 * rkc;
            float* o = ops + (size_t)(m0 + t) * 1792 + c;
            o[0] = rr; o[256] = decay; o[512] = k2; o[768] = v; o[1024] = kk; o[1280] = kk * a; o[1536] = ag[nt][r];
        }
    }
#pragma unroll
    for (int r = 0; r < 4; ++r) { const float s = dpp_sum16(rks[r]); if (fr == 0) rk[(size_t)(m0 + 4 * g + r) * 4 + h] = s; }
    __syncthreads();
}
__device__ __forceinline__ void hg_m1_row(int m, int t256, const bf16* z, const float* logits, int layer, float* hg) {
    for (int c = t256; c < 512; c += 256) {
        const bf16* zr = z + (size_t)m * NIN + 1024;
        const float q = bf2f(zr[c]), fz = bf2f(zr[512 + c]), iv = bf2f(zr[1024 + c]);
        float lb = 0.f;
        if (layer == 1) { const float l0 = logits[c], l1 = logits[512 + c]; lb = 1.0f / (1.0f + expf(l0 - l1)); }
        const float f = lb + (1.0f - lb) * sigmoidf_(fz);
        float* o = hg + (size_t)(m - MP) * 1536;
        o[c] = siluf_(q); o[512 + c] = f; o[1024 + c] = iv;
    }
}
__device__ __forceinline__ void cm_p_pair(const Ctx& C, int pair, const bf16* z, const bf16* Wc  , const float* bs, const float* ln_g, const float* ln_b, bf16* ob) {
    constexpr int VS = 136;
    LAS bf16* vnT = (LAS bf16*)(C.lds + C.half * 32768);
    const int item = 2 * pair + C.half, h = item & 3, ch = item >> 2;
    const int m0 = ch * 128, lane = C.lane, w = C.t256 >> 6, g = lane >> 4, fr = lane & 15;
    {
        float val[32];
#pragma unroll
        for (int i = 0; i < 32; ++i) val[i] = bf2f(z[(size_t)(m0 + w + 4 * i) * NIN + 3072 + 256 + h * 64 + lane]);
        const float lg = ln_g[h * 64 + lane], lb = ln_b[h * 64 + lane];
#pragma unroll
        for (int i = 0; i < 32; ++i) {
            const float x = geluf_(val[i]);
            const float mean = wave_sum(x) * (1.f / 64.f); const float d = x - mean; const float var = wave_sum(d * d) * (1.f / 64.f);
            vnT[lane * VS + w + 4 * i] = (bf16)f2bf(d * rsqrtf(var + 1e-5f) * lg + lb);
        }
    }
    __syncthreads();
    f32x4 acc[2][4];
#pragma unroll
    for (int i = 0; i < 2; ++i)
#pragma unroll
        for (int dt = 0; dt < 4; ++dt) acc[i][dt] = (f32x4){0.f, 0.f, 0.f, 0.f};
#pragma unroll
    for (int ks = 0; ks < 4; ++ks) {
        bf16x8 bfr[4];
#pragma unroll
        for (int dt = 0; dt < 4; ++dt) bfr[dt] = *(const LAS bf16x8*)(vnT + (16 * dt + fr) * VS + 32 * ks + 8 * g);
#pragma unroll
        for (int i = 0; i < 2; ++i) {
            const bf16x8 af = *(const bf16x8*)(Wc + ((size_t)h * 128 + 16 * (2 * w + i) + fr) * 128 + 32 * ks + 8 * g);
#pragma unroll
            for (int dt = 0; dt < 4; ++dt) acc[i][dt] = __builtin_amdgcn_mfma_f32_16x16x32_bf16(af, bfr[dt], acc[i][dt], 0, 0, 0);
        }
    }
#pragma unroll
    for (int i = 0; i < 2; ++i)
#pragma unroll
        for (int r = 0; r < 4; ++r) {
            const int t = 16 * (2 * w + i) + 4 * g + r; const float bias = bs[h * 128 + t];
#pragma unroll
            for (int dt = 0; dt < 4; ++dt) {
                const int d = 16 * dt + fr;
                const float u = geluf_(bf2f(z[(size_t)(m0 + t) * NIN + 3072 + h * 64 + d]));
                ob[(size_t)(m0 + t) * D + 768 + h * 64 + d] = (bf16)f2bf(u * (acc[i][dt][r] + bias));
            }
        }
    __syncthreads();
}
__device__ __forceinline__ void cm_s_seq(int b, int c, const bf16* z, const float* ws_, const float* bs, const float* ln_g, const float* ln_b, bf16* ob, float* cmv) {
    const int h = c >> 6;
    float vn[DS];
#pragma unroll
    for (int t = 0; t < DS; ++t) {
        const int m = MP + b * DS + t;
        const float val = geluf_(bf2f(z[(size_t)m * NIN + 3072 + 256 + c]));
        const float mean = wave_sum(val) * (1.f / 64.f); const float d = val - mean; const float var = wave_sum(d * d) * (1.f / 64.f);
        vn[t] = d * rsqrtf(var + 1e-5f) * ln_g[c] + ln_b[c];
        cmv[((size_t)b * DS + t) * 256 + c] = vn[t];
    }
#pragma unroll
    for (int t = 0; t < DS; ++t) {
        const int m = MP + b * DS + t;
        float acc = bs[h * 128 + t];
#pragma unroll
        for (int s = 0; s <= t; ++s) acc += ws_[((size_t)h * 128 + t) * 128 + s] * vn[s];
        const float u = geluf_(bf2f(z[(size_t)m * NIN + 3072 + c]));
        ob[(size_t)m * D + 768 + c] = (bf16)f2bf(u * acc);
    }
}
__device__ __forceinline__ float dpp_sum8(float x) {
    x += __builtin_bit_cast(float, __builtin_amdgcn_update_dpp(0, __builtin_bit_cast(int, x), 0xB1, 0xF, 0xF, true));
    x += __builtin_bit_cast(float, __builtin_amdgcn_update_dpp(0, __builtin_bit_cast(int, x), 0x4E, 0xF, 0xF, true));
    x += __builtin_bit_cast(float, __builtin_amdgcn_update_dpp(0, __builtin_bit_cast(int, x), 0x141, 0xF, 0xF, true));
    return x;
}
__device__ __forceinline__ void rw_sample_task(int task, int lane, const float* ops, const float* S0, float* rawo, float* Ss) {
    const int rg = task & 7, h = (task >> 3) & 3, seq = task >> 5;
    const int row = rg * 8 + (lane >> 3), kq = lane & 7;
    const size_t sidx = (((size_t)seq * 4 + h) * 64 + row) * 64 + kq * 8;
    const f32x4 i0 = *(const f32x4*)(S0 + sidx), i1 = *(const f32x4*)(S0 + sidx + 4);
    float s[8] = {i0.x, i0.y, i0.z, i0.w, i1.x, i1.y, i1.z, i1.w};
#pragma unroll
    for (int t = 0; t < DS; ++t) {
        const float* op = ops + (size_t)(MP + seq * DS + t) * 1792 + h * 64;
        const f32x4 r0 = *(const f32x4*)(op + 0 * 256 + kq * 8), r1 = *(const f32x4*)(op + 0 * 256 + kq * 8 + 4);
        const f32x4 w0 = *(const f32x4*)(op + 1 * 256 + kq * 8), w1 = *(const f32x4*)(op + 1 * 256 + kq * 8 + 4);
        const f32x4 k0 = *(const f32x4*)(op + 2 * 256 + kq * 8), k1 = *(const f32x4*)(op + 2 * 256 + kq * 8 + 4);
        const float vv = op[3 * 256 + row];
        const f32x4 q0 = *(const f32x4*)(op + 4 * 256 + kq * 8), q1 = *(const f32x4*)(op + 4 * 256 + kq * 8 + 4);
        const f32x4 b0 = *(const f32x4*)(op + 5 * 256 + kq * 8), b1 = *(const f32x4*)(op + 5 * 256 + kq * 8 + 4);
        float sp = (s[0] * q0.x + s[1] * q0.y) + (s[2] * q0.z + s[3] * q0.w) + ((s[4] * q1.x + s[5] * q1.y) + (s[6] * q1.z + s[7] * q1.w));
        const float sa = -dpp_sum8(sp);
        s[0] = s[0] * w0.x + (sa * b0.x + vv * k0.x); s[1] = s[1] * w0.y + (sa * b0.y + vv * k0.y); s[2] = s[2] * w0.z + (sa * b0.z + vv * k0.z); s[3] = s[3] * w0.w + (sa * b0.w + vv * k0.w);
        s[4] = s[4] * w1.x + (sa * b1.x + vv * k1.x); s[5] = s[5] * w1.y + (sa * b1.y + vv * k1.y); s[6] = s[6] * w1.z + (sa * b1.z + vv * k1.z); s[7] = s[7] * w1.w + (sa * b1.w + vv * k1.w);
        float o = (s[0] * r0.x + s[1] * r0.y) + (s[2] * r0.z + s[3] * r0.w) + ((s[4] * r1.x + s[5] * r1.y) + (s[6] * r1.z + s[7] * r1.w));
        o = dpp_sum8(o);
        if (kq == 0) rawo[(size_t)(MP + seq * DS + t) * 256 + h * 64 + row] = o;
    }
    *(f32x4*)(Ss + sidx) = (f32x4){s[0], s[1], s[2], s[3]}; *(f32x4*)(Ss + sidx + 4) = (f32x4){s[4], s[5], s[6], s[7]};
}
__device__ __forceinline__ void hg_sample_task(int task, int lane, LAS float* tab  , const float* hgs, const float* S0, float* rawo, float* Ss) {
    typedef float f32x2 __attribute__((ext_vector_type(2)));
    const int h = task & 3, seq = task >> 2;
#pragma unroll
    for (int t = 0; t < DS; ++t) {
        const float* hr = hgs + (size_t)(seq * DS + t) * 1536 + h * 128;
        tab[lane * 8 + t] = hr[512 + lane]; tab[(lane + 64) * 8 + t] = hr[512 + lane + 64];
        tab[lane * 8 + 4 + t] = hr[lane]; tab[(lane + 64) * 8 + 4 + t] = hr[lane + 64];
    }
    f32x2 iv[DS], o[DS];
#pragma unroll
    for (int t = 0; t < DS; ++t) { iv[t] = *(const f32x2*)(hgs + (size_t)(seq * DS + t) * 1536 + 1024 + h * 128 + 2 * lane); o[t] = (f32x2){0.f, 0.f}; }
    const size_t sbase = ((size_t)seq * 4 + h) * 16384 + 2 * lane;
    asm volatile("s_waitcnt lgkmcnt(0)" ::: "memory");
#pragma unroll 8
    for (int k = 0; k < 128; ++k) {
        f32x2 s = *(const f32x2*)(S0 + sbase + (size_t)k * 128);
        const f32x4 f = *(const LAS f32x4*)(tab + k * 8), q = *(const LAS f32x4*)(tab + k * 8 + 4);
        s = s * f.x + iv[0] * (1.0f - f.x); o[0] += s * q.x;
        s = s * f.y + iv[1] * (1.0f - f.y); o[1] += s * q.y;
        s = s * f.z + iv[2] * (1.0f - f.z); o[2] += s * q.z;
        s = s * f.w + iv[3] * (1.0f - f.w); o[3] += s * q.w;
        *(f32x2*)(Ss + sbase + (size_t)k * 128) = s;
    }
#pragma unroll
    for (int t = 0; t < DS; ++t) *(f32x2*)(rawo + (size_t)(MP + seq * DS + t) * 512 + h * 128 + 2 * lane) = o[t];
    asm volatile("s_waitcnt lgkmcnt(0)" ::: "memory");
}

__device__ __forceinline__ int hg_perm(int k) { const int i32 = k & ~31, k5 = k & 31; return k5 < 16 ? i32 + 8 * (k5 >> 2) + (k5 & 3) : i32 + 8 * ((k5 - 16) >> 2) + 4 + (k5 & 3); }
__device__ __forceinline__ void hg_m1_pair(const Ctx& C, int pair, const bf16* z, const float* logits, int layer, bf16* QP, bf16* KT, bf16* VT, float* DD, bf16* AA) {
    constexpr int LS = 132;
    LAS float* qs = (LAS float*)(C.lds + RING_OFF + C.half * 32768);
    LAS float* kl = qs + 16 * LS;
    LAS float* cu = kl + 16 * LS;
    const int unit = 2 * pair + C.half, h = unit & 3, m0 = (unit >> 2) * 16, tid = C.t256;
    if (tid < 128) {
        const int k = tid; float lb = 0.f;
        if (layer == 1) { const float l0 = logits[h * 128 + k], l1 = logits[512 + h * 128 + k]; lb = 1.0f / (1.0f + expf(l0 - l1)); }
        float cum = 0.f; bf16 zq[16], zf[16];
#pragma unroll
        for (int t = 0; t < 16; ++t) { const bf16* zr = z + (size_t)(m0 + t) * NIN + 1024 + h * 128 + k; zq[t] = zr[0]; zf[t] = zr[512]; }
#pragma unroll
        for (int t = 0; t < 16; ++t) {
            const float q = bf2f(zq[t]), fz = bf2f(zf[t]);
            const float f = lb + (1.0f - lb) * sigmoidf_(fz);
            cum += logf(fmaxf(f, 1e-30f));
            qs[t * LS + k] = siluf_(q); kl[t * LS + k] = 1.0f - f; cu[t * LS + k] = cum;
        }
    } else {
        const int v = tid - 128; unsigned w[8]; bf16 zi[16];
#pragma unroll
        for (int t = 0; t < 16; ++t) zi[t] = z[(size_t)(m0 + t) * NIN + 1024 + 1024 + h * 128 + v];
#pragma unroll
        for (int t = 0; t < 16; t += 2) w[t >> 1] = (unsigned)zi[t] | ((unsigned)zi[t + 1] << 16);
        v4u* dst = (v4u*)(VT + ((size_t)unit * 128 + v) * 16);
        dst[0] = (v4u){w[0], w[1], w[2], w[3]}; dst[1] = (v4u){w[4], w[5], w[6], w[7]};
    }
    __syncthreads();
    if (tid < 128) {
        const int k = tid; const float cl = cu[15 * LS + k]; unsigned w[8];
        DD[(size_t)unit * 128 + k] = expf(cl);
        const int pk = hg_perm(k);
#pragma unroll
        for (int t = 0; t < 16; t += 2) {
            const float c0 = cu[t * LS + k], c1 = cu[(t + 1) * LS + k];
            w[t >> 1] = pk2(kl[t * LS + k] * expf(cl - c0), kl[(t + 1) * LS + k] * expf(cl - c1));
            QP[((size_t)unit * 16 + t) * 128 + pk] = (bf16)f2bf(qs[t * LS + k] * expf(c0));
            QP[((size_t)unit * 16 + t + 1) * 128 + pk] = (bf16)f2bf(qs[(t + 1) * LS + k] * expf(c1));
        }
        v4u* dst = (v4u*)(KT + ((size_t)unit * 128 + k) * 16);
        dst[0] = (v4u){w[0], w[1], w[2], w[3]}; dst[1] = (v4u){w[4], w[5], w[6], w[7]};
    }
    {
        const int t = tid >> 4, s = tid & 15; float a = 0.f;
        if (s <= t) {
            const LAS f32x4* q4 = (const LAS f32x4*)(qs + t * LS); const LAS f32x4* ct4 = (const LAS f32x4*)(cu + t * LS);
            const LAS f32x4* k4 = (const LAS f32x4*)(kl + s * LS); const LAS f32x4* cs4 = (const LAS f32x4*)(cu + s * LS);
#pragma unroll 4
            for (int j = 0; j < 32; ++j) {
                const f32x4 q = q4[j], kk = k4[j], d = ct4[j] - cs4[j];
                a += q.x * kk.x * __expf(d.x) + q.y * kk.y * __expf(d.y) + q.z * kk.z * __expf(d.z) + q.w * kk.w * __expf(d.w);
            }
        }
        AA[(size_t)unit * 256 + tid] = (bf16)f2bf(a);
    }
    __syncthreads();
}

__device__ __forceinline__ void hg_scan_prompt(const Ctx& C, int bh, const bf16* QP, const bf16* KT, const bf16* VT, const float* DD, const bf16* AA, float* rawo, float* Sp) {
    constexpr int BUF = 14336, QROW = 272;
    LAS unsigned char* base = C.lds + RING_OFF;
    const int b = bh >> 2, h = bh & 3, tid = C.tid, lane = C.lane, w = C.wave, g = lane >> 4, fr = lane & 15;
    const int pc0 = tid, pc1 = tid + 512;
    auto src_of = [&](int pc, size_t unit) -> const v4u* {
        if (pc < 256) return (const v4u*)(QP + unit * 2048) + pc;
        if (pc < 512) return (const v4u*)(KT + unit * 2048) + (pc - 256);
        if (pc < 768) return (const v4u*)(VT + unit * 2048) + (pc - 512);
        if (pc < 800) return (const v4u*)(DD + unit * 128) + (pc - 768);
        return (const v4u*)(AA + unit * 256) + (pc - 800);
    };
    auto dst_of = [&](int pc) -> int {
        if (pc < 256) return (pc >> 4) * QROW + (pc & 15) * 16;
        if (pc < 512) return 4352 + (pc - 256) * 16;
        if (pc < 768) return 8448 + (pc - 512) * 16;
        if (pc < 800) return 12544 + (pc - 768) * 16;
        return 13056 + (pc - 800) * 16;
    };
    const int d0 = dst_of(pc0), d1 = dst_of(pc1 < 832 ? pc1 : 0);
    const size_t unit0 = ((size_t)b * 128) * 4 + h;
    f32x4 acc[8];
#pragma unroll
    for (int kt = 0; kt < 8; ++kt) acc[kt] = (f32x4){0.f, 0.f, 0.f, 0.f};
    constexpr int NC = SEQ / 16;
    const bool two = pc1 < 832;
    v4u pr[8][2];
#pragma unroll
    for (int j = 0; j < 8; ++j) { pr[j][0] = *src_of(pc0, unit0 + 4 * (size_t)j); pr[j][1] = two ? *src_of(pc1, unit0 + 4 * (size_t)j) : (v4u){0u, 0u, 0u, 0u}; }
    *(LAS v4u*)(base + d0) = pr[0][0]; if (two) *(LAS v4u*)(base + d1) = pr[0][1];
    pr[0][0] = *src_of(pc0, unit0 + 4 * (size_t)8); if (two) pr[0][1] = *src_of(pc1, unit0 + 4 * (size_t)8);
    asm volatile("s_waitcnt lgkmcnt(0)" ::: "memory"); __builtin_amdgcn_s_barrier(); asm volatile("" ::: "memory");
    for (int cc = 0; cc < NC / 8; ++cc) {
#pragma unroll
        for (int j = 0; j < 8; ++j) {
            const int c = 8 * cc + j;
            LAS unsigned char* buf = base + (j & 1) * BUF;
            const bf16x8 zero8 = (bf16x8){0, 0, 0, 0, 0, 0, 0, 0};
            bf16x8 aA = *(const LAS bf16x8*)(buf + 13056 + fr * 32 + (g & 1) * 16);
            bf16x8 bV = *(const LAS bf16x8*)(buf + 8448 + (16 * w + fr) * 32 + (g & 1) * 16);
            if (g >= 2) { aA = zero8; bV = zero8; }
            f32x4 o = __builtin_amdgcn_mfma_f32_16x16x32_bf16(aA, bV, (f32x4){0.f, 0.f, 0.f, 0.f}, 0, 0, 0);
#pragma unroll
            for (int i = 0; i < 4; ++i) {
                const bf16x8 aQ = *(const LAS bf16x8*)(buf + fr * QROW + 64 * i + 16 * g);
                const f32x4 s0 = acc[2 * i], s1 = acc[2 * i + 1];
                v4u bw; bw.x = pk2(s0[0], s0[1]); bw.y = pk2(s0[2], s0[3]); bw.z = pk2(s1[0], s1[1]); bw.w = pk2(s1[2], s1[3]);
                o = __builtin_amdgcn_mfma_f32_16x16x32_bf16(aQ, __builtin_bit_cast(bf16x8, bw), o, 0, 0, 0);
            }
#pragma unroll
            for (int kt = 0; kt < 8; ++kt) {
                bf16x8 aK = *(const LAS bf16x8*)(buf + 4352 + (16 * kt + fr) * 32 + (g & 1) * 16);
                if (g >= 2) aK = zero8;
                const f32x4 dd = *(const LAS f32x4*)(buf + 12544 + (16 * kt + 4 * g) * 4);
                acc[kt] = __builtin_amdgcn_mfma_f32_16x16x32_bf16(aK, bV, acc[kt] * dd, 0, 0, 0);
            }
            {
                float* op = rawo + ((size_t)b * SEQ + 16 * c + 4 * g) * 512 + h * 128 + 16 * w + fr;
#pragma unroll
                for (int r = 0; r < 4; ++r) op[(size_t)r * 512] = o[r];
            }
            if (c + 1 < NC) {
                LAS unsigned char* nb = base + ((j + 1) & 1) * BUF;
                *(LAS v4u*)(nb + d0) = pr[(j + 1) & 7][0]; if (two) *(LAS v4u*)(nb + d1) = pr[(j + 1) & 7][1];
                if (c + 9 < NC) { pr[(j + 1) & 7][0] = *src_of(pc0, unit0 + 4 * (size_t)(c + 9)); if (two) pr[(j + 1) & 7][1] = *src_of(pc1, unit0 + 4 * (size_t)(c + 9)); }
            }
            asm volatile("s_waitcnt lgkmcnt(0)" ::: "memory"); __builtin_amdgcn_s_barrier(); asm volatile("" ::: "memory");
        }
    }
    float* so = Sp + ((size_t)bh * 128) * 128 + 16 * w + fr;
#pragma unroll
    for (int kt = 0; kt < 8; ++kt)
#pragma unroll
        for (int r = 0; r < 4; ++r) so[(size_t)(16 * kt + 4 * g + r) * 128] = acc[kt][r];
}

__device__ __forceinline__ void rw_scan_prompt(const Ctx& C, int blk, const float* ops, float* rawo, float* Sp) {
    constexpr int BUF = 24576, NB = 5, NC = SEQ / 16;
    LAS unsigned char* base = C.lds + RING_OFF;
    const int bh = blk >> 1, hf = blk & 1, b = bh >> 2, h = bh & 3, lane = C.lane, w = C.wave;
    const size_t mrow0 = (size_t)b * SEQ;
    if (w >= 4) {
        const int lw = w - 4, tl = C.tid - 256;
        unsigned soff[6];
#pragma unroll
        for (int i = 0; i < 6; ++i) { const int q = i * 256 + tl, seg = q >> 4, part = q & 15, t = seg / 6, f = seg % 6; soff[i] = (unsigned)(t * 1792 + f * 256 + h * 64 + part * 4); }
        auto issue = [&](int c, int slot) {
            const float* src = ops + (mrow0 + 16 * (size_t)(c < NC ? c : c - NC)) * 1792;
#pragma unroll
            for (int i = 0; i < 6; ++i)
                __builtin_amdgcn_global_load_lds((const unsigned*)(src + soff[i]), (LAS unsigned*)(base + slot * BUF + (i * 256 + lw * 64) * 16), 16, 0, 0);
        };
        issue(0, 0); issue(1, 1); issue(2, 2); issue(3, 3);
        int slot = 4;
        for (int c = 0; c < NC; ++c) {
            asm volatile("s_waitcnt vmcnt(18)" ::: "memory");
            __builtin_amdgcn_s_barrier();
            issue(c + 4, slot); slot = slot == NB - 1 ? 0 : slot + 1;
        }
        asm volatile("s_waitcnt vmcnt(0)" ::: "memory");
        __builtin_amdgcn_s_barrier();
    } else {
        typedef float f32x2 __attribute__((ext_vector_type(2)));
        struct StepOps { f32x4 r0, r1, w0, w1, k0, k1, q0, q1, b0, b1; float v; };
        const int rg = hf * 4 + w, row = rg * 8 + (lane >> 3), kq = lane & 7;
        f32x2 s01 = {0.f, 0.f}, s23 = {0.f, 0.f}, s45 = {0.f, 0.f}, s67 = {0.f, 0.f};
        auto ld = [&](const LAS unsigned char* st) -> StepOps {
            StepOps o;
            o.r0 = *(const LAS f32x4*)(st + 0 * 256 + kq * 32); o.r1 = *(const LAS f32x4*)(st + 0 * 256 + kq * 32 + 16);
            o.w0 = *(const LAS f32x4*)(st + 1 * 256 + kq * 32); o.w1 = *(const LAS f32x4*)(st + 1 * 256 + kq * 32 + 16);
            o.k0 = *(const LAS f32x4*)(st + 2 * 256 + kq * 32); o.k1 = *(const LAS f32x4*)(st + 2 * 256 + kq * 32 + 16);
            o.v = *(const LAS float*)(st + 3 * 256 + row * 4);
            o.q0 = *(const LAS f32x4*)(st + 4 * 256 + kq * 32); o.q1 = *(const LAS f32x4*)(st + 4 * 256 + kq * 32 + 16);
            o.b0 = *(const LAS f32x4*)(st + 5 * 256 + kq * 32); o.b1 = *(const LAS f32x4*)(st + 5 * 256 + kq * 32 + 16);
            return o;
        };
#define LO2(v4) ((f32x2){(v4).x, (v4).y})
#define HI2(v4) ((f32x2){(v4).z, (v4).w})
        int slot = 0;
        float okeep = 0.f;
        float* orow = rawo + mrow0 * 256 + h * 64 + row + (size_t)kq * 256;
        for (int c = 0; c < NC; ++c) {
            __builtin_amdgcn_s_barrier(); asm volatile("" ::: "memory");
            const LAS unsigned char* buf = base + slot * BUF; slot = slot == NB - 1 ? 0 : slot + 1;
            StepOps cur = ld(buf);
#pragma unroll
            for (int t = 0; t < 16; ++t) {
                StepOps nxt = cur;
                if (t + 1 < 16) nxt = ld(buf + (t + 1) * 1536);
                f32x2 p = s01 * LO2(cur.q0); p = s23 * HI2(cur.q0) + p;
                f32x2 p2 = s45 * LO2(cur.q1); p2 = s67 * HI2(cur.q1) + p2;
                p = p + p2;
                const float sa = -dpp_sum8(p.x + p.y);
                const f32x2 sa2 = {sa, sa}, vv2 = {cur.v, cur.v};
                s01 = s01 * LO2(cur.w0) + (sa2 * LO2(cur.b0) + vv2 * LO2(cur.k0));
                s23 = s23 * HI2(cur.w0) + (sa2 * HI2(cur.b0) + vv2 * HI2(cur.k0));
                s45 = s45 * LO2(cur.w1) + (sa2 * LO2(cur.b1) + vv2 * LO2(cur.k1));
                s67 = s67 * HI2(cur.w1) + (sa2 * HI2(cur.b1) + vv2 * HI2(cur.k1));
                f32x2 u = s01 * LO2(cur.r0); u = s23 * HI2(cur.r0) + u;
                f32x2 u2 = s45 * LO2(cur.r1); u2 = s67 * HI2(cur.r1) + u2;
                u = u + u2;
                const float ov = dpp_sum8(u.x + u.y);
                okeep = ((t & 7) == kq) ? ov : okeep;
                if ((t & 7) == 7) orow[(size_t)(16 * c + (t & 8)) * 256] = okeep;
                cur = nxt;
            }
            asm volatile("" ::: "memory");
        }
#undef LO2
#undef HI2
        float* so = Sp + (((size_t)bh * 64) + row) * 64 + kq * 8;
        *(f32x4*)so = (f32x4){s01.x, s01.y, s23.x, s23.y}; *(f32x4*)(so + 4) = (f32x4){s45.x, s45.y, s67.x, s67.y};
        __builtin_amdgcn_s_barrier();
    }
}

__device__ __forceinline__ void m3_row(int m, int tid, const bf16* z, const float* ops, const float* rk, const float* rwo, const float* hgo,
                                       const float* gn_g, const float* gn_b, const float* norm_g, bf16* ob) {
    const int h = tid >> 6;
    {
        const float o = rwo[(size_t)m * 256 + tid];
        const float mean = wave_sum(o) * (1.f / 64.f); const float d = o - mean; const float var = wave_sum(d * d) * (1.f / 64.f);
        float on = d * rsqrtf(var + 64e-5f) * gn_g[tid] + gn_b[tid];
        const float* op = ops + (size_t)m * 1792;
        on += rk[(size_t)m * 4 + h] * op[768 + tid];
        on *= op[1536 + tid];
        ob[(size_t)m * D + tid] = (bf16)f2bf(on);
    }
    {
        const int c = 2 * tid;
        const float o0 = hgo[(size_t)m * 512 + c], o1 = hgo[(size_t)m * 512 + c + 1];
        const float ms = wave_sum(o0 * o0 + o1 * o1) * (1.f / 128.f);
        const float rs = rsqrtf(ms + 1e-6f);
        const float og0 = bf2f(z[(size_t)m * NIN + 1024 + 1536 + c]), og1 = bf2f(z[(size_t)m * NIN + 1024 + 1536 + c + 1]);
        *(unsigned*)(ob + (size_t)m * D + 256 + c) = pk2(o0 * rs * norm_g[c] * siluf_(og0), o1 * rs * norm_g[c + 1] * siluf_(og1));
    }
}

constexpr int PH_PER_LAYER = 12, N_PHASES = 1 + DEPTH * PH_PER_LAYER;
struct Args { const float* in[34]; float* out; unsigned char* ws; int ph_lo, ph_hi; unsigned char plist[64]; };
__global__ void __launch_bounds__(NWAVES * 64, 2) mk_fwd(Args args) {
    extern __shared__ __attribute__((aligned(16))) unsigned char lds_raw[];
    Ctx C;
    C.lds = (LAS unsigned char*)lds_raw;
    C.tid = threadIdx.x; C.lane = C.tid & 63; C.wave = __builtin_amdgcn_readfirstlane(C.tid >> 6); C.half = C.wave >> 2; C.t256 = C.tid & 255;
    C.G = gridDim.x; C.gw = C.wave * C.G + blockIdx.x; C.NGW = C.G * NWAVES;
#define REFRESH_CTX() do { int t_ = threadIdx.x; asm volatile("" : "+v"(t_)); C.tid = t_; C.lane = t_ & 63; C.wave = __builtin_amdgcn_readfirstlane(t_ >> 6); C.half = C.wave >> 2; C.t256 = t_ & 255; \
        C.gw = C.wave * C.G + blockIdx.x; } while (0)
    volatile LAS unsigned* MISC = (volatile LAS unsigned*)(C.lds + MISC_OFF);
    unsigned char* ws = args.ws; const float* const* in = args.in; float* out = args.out;
    gu32* ctl = (gu32*)(ws + WS_CTL);
    for (int u = C.tid; u < (LDS_BYTES - LDSCTL_OFF) / 4; u += NWAVES * 64) ((LAS unsigned*)(C.lds + LDSCTL_OFF))[u] = 0u;
    __syncthreads();
    XcdBarrier bar; bar.bar = (unsigned*)(ctl + CW_BAR); bar.x = 0; bar.st = nullptr;
    if (!MK_SPLIT) bar = xcd_barrier_post((unsigned*)(ctl + CW_BAR), MISC + 8);
    const int lo = args.ph_lo, hi = args.ph_hi;
    float* X = out + O_Y;
    bf16* XB = (bf16*)(ws + WS_XB); bf16* OB = (bf16*)(ws + WS_OB); bf16* HZ = (bf16*)(ws + WS_HZ);
    float* RW = (float*)(ws + WS_RW); float* RK = (float*)(ws + WS_RK); float* HG = (float*)(ws + WS_HG); bf16* QP = (bf16*)(ws + WS_QP); bf16* KT = (bf16*)(ws + WS_KT); bf16* VT = (bf16*)(ws + WS_VT); float* DD = (float*)(ws + WS_DD); bf16* AA = (bf16*)(ws + WS_AA); float* RWO = (float*)(ws + WS_RWO); float* HGO = (float*)(ws + WS_HGO);

    for (int it = lo; it < hi; ++it) {
        const int pe_ = args.plist[it]; const int ph = pe_ & 127, rep_ = pe_ >> 7;
        REFRESH_CTX();
        if (ph == 0) {
            phase_prologue(C, in, ws, X, XB);
        } else {
            const int l = (ph - 1) / PH_PER_LAYER, p = (ph - 1) % PH_PER_LAYER;
            const char* wl = (const char*)(ws + WS_W + (size_t)l * W_LAYER);
            if (p == 0 || p == 9) {
                pg8::Gemm g{XB, (const bf16*)(wl + (p == 0 ? W_1IN : W_2IN)), M, 2 * DFF, D}; pg8::StaticOrder S; S.init(M, 2 * DFF, C.G, (int)blockIdx.x);
                pg8::EpiSwiGLU E{HZ, DFF};
                pg8::gemm_phase<pg8::EpiSwiGLU, pg8::StaticOrder, PG8_ALIGN, PG8_SP2>(C.lds + RING_OFF, g, S, E, C.tid);
            } else if (p == 1 || p == 10) {
                pg8::Gemm g{HZ, (const bf16*)(wl + (p == 1 ? W_1OUT : W_2OUT)), M, D, DFF}; pg8::StaticOrder S; S.init(M, D, C.G, (int)blockIdx.x);
                pg8::EpiResidual E{X, D, rep_ ? 1.0f : ALPHA, rep_ ? 0.0f : 0.5f};
                pg8::gemm_phase<pg8::EpiResidual, pg8::StaticOrder, PG8_ALIGN, PG8_SP2>(C.lds + RING_OFF, g, S, E, C.tid);
            } else if (p == 2 || p == 8 || p == 11) {
                const int gi = p == 2 ? 7 : (p == 8 ? 11 : 32);
                phase_ln(C, X, XB, in[gi] + l * D, in[gi + 1] + l * D);
            } else if (p == 3) {
                pg8::Gemm g{XB, (const bf16*)(wl + W_MI), M, NIN, D}; pg8::StaticOrder S; S.init(M, NIN, C.G, (int)blockIdx.x);
                pg8::EpiStoreBf16 E{HZ, NIN};
                pg8::gemm_phase<pg8::EpiStoreBf16, pg8::StaticOrder, PG8_ALIGN, PG8_SP2>(C.lds + RING_OFF, g, S, E, C.tid);
            } else if (p == 4) {
                RwParams P{in[13] + l * 1024, in[14] + l * 256, in[15] + (size_t)l * 64 * 256, in[16] + l * 256, in[17] + (size_t)l * 64 * 256, in[18] + (size_t)l * 128 * 256, in[19] + l * 256, in[20] + l * 256, in[21] + l * 256};
                const int sub = rep_ ? PROBE_SUB : 0xFF;
                if (sub & 1) for (int pr = blockIdx.x; pr < M / 32; pr += C.G)
                    rw_m1_pair(C, pr, HZ, in[3] + (size_t)l * DB * 1024, P, (const bf16*)(ws + WS_LW + (size_t)l * LW_LAYER), RW, RK, out + O_RWSHP + (size_t)l * BATCH * 1024, out + O_RWSHS + (size_t)l * DB * 1024);
                if (sub & 2) for (int pr = blockIdx.x; pr < BATCH * 16 * 4 / 2; pr += C.G)
                    cm_p_pair(C, pr, HZ, (const bf16*)(ws + WS_LW + (size_t)l * LW_LAYER + LW_CM), in[27] + l * 512, in[28] + l * 256, in[29] + l * 256, OB);
                if (sub & 4) for (int pr = blockIdx.x; pr < (MP / 16) * 4 / 2; pr += C.G) hg_m1_pair(C, pr, HZ, in[24], l, QP, KT, VT, DD, AA);
                if (sub & 8) for (int m = MP + blockIdx.x * 2 + C.half; m < M; m += 2 * C.G) hg_m1_row(m, C.t256, HZ, in[24], l, HG);
                if (sub & 8) for (int b = blockIdx.x * 2 + C.half; b < DB; b += 2 * C.G)
                    cm_s_seq(b, C.t256, HZ, in[26] + (size_t)l * 4 * 128 * 128, in[27] + l * 512, in[28] + l * 256, in[29] + l * 256, OB, out + O_CMV + (size_t)l * DB * DS * 256);
            } else if (p == 5) {
                const float* rwS0 = in[2] + (size_t)l * DB * 4 * 4096; const float* hgS0 = in[4] + (size_t)l * DB * 4 * 16384;
                float* rwSp = out + O_RWSP + (size_t)l * BATCH * 4 * 4096; float* rwSs = out + O_RWSS + (size_t)l * DB * 4 * 4096;
                float* hgSp = out + O_HGSP + (size_t)l * BATCH * 4 * 16384; float* hgSs = out + O_HGSS + (size_t)l * DB * 4 * 16384;
                const int blk = blockIdx.x;
                const int sub = rep_ ? PROBE_SUB : 0xFF;
                if (blk < 64) { if (sub & 1) rw_scan_prompt(C, blk, RW, RWO, rwSp); }
                else if (blk < 96) { if (sub & 2) hg_scan_prompt(C, blk - 64, QP, KT, VT, DD, AA, HGO, hgSp); }
                else if (sub & 4) {
                    const int NT_HGS = DB * 4, NT_RWS = DB * 4 * 8;
                    LAS float* tab = (LAS float*)(C.lds + RING_OFF + C.wave * 4096);
                    for (int task = (blk - 96) + 160 * C.wave; task < NT_HGS + NT_RWS; task += 160 * NWAVES) {
                        if (task < NT_HGS) hg_sample_task(task, C.lane, tab, HG, hgS0, HGO, hgSs);
                        else rw_sample_task(task - NT_HGS, C.lane, RW, rwS0, RWO, rwSs);
                    }
                }
            } else if (p == 6) {
                for (int m = blockIdx.x * 2 + C.half; m < M; m += 2 * C.G)
                    m3_row(m, C.t256, HZ, RW, RK, RWO, HGO, in[22] + l * 256, in[23] + l * 256, in[25] + l * 512, OB);
            } else if (p == 7) {
                pg8::Gemm g{OB, (const bf16*)(wl + W_MO), M, D, D}; pg8::StaticOrder S; S.init(M, D, C.G, (int)blockIdx.x);
                pg8::EpiResidual E{X, D, rep_ ? 1.0f : ALPHA, rep_ ? 0.0f : 1.0f};
                pg8::gemm_phase<pg8::EpiResidual, pg8::StaticOrder, PG8_ALIGN, PG8_SP2>(C.lds + RING_OFF, g, S, E, C.tid);
            }
        }
        if (PROBE_KIND == 9 && it + 1 < hi) xcd_barrier(bar);
        if (it + 1 < hi) xcd_barrier(bar);
    }
}

extern "C" void kernel_launch(void* const* d_in, const int* in_sizes, int n_in, void* d_out, int out_size, void* d_ws, size_t ws_size, hipStream_t stream) {
    static int grid = 0;
    if (grid == 0) {
        if (n_in != 34 || ws_size < WS_END) { fprintf(stderr, "kernel_launch: unexpected n_in %d or ws_size %zu; nothing launched\n", n_in, ws_size); grid = -1; return; }
        int dev = 0, cus = 0, per_cu = 0;
        if (hipGetDevice(&dev) != hipSuccess || hipDeviceGetAttribute(&cus, hipDeviceAttributeMultiprocessorCount, dev) != hipSuccess) { grid = -1; return; }
        if (hipFuncSetAttribute((const void*)mk_fwd, hipFuncAttributeMaxDynamicSharedMemorySize, LDS_BYTES) != hipSuccess) { fprintf(stderr, "kernel_launch: hipFuncSetAttribute failed\n"); grid = -1; return; }
        if (hipOccupancyMaxActiveBlocksPerMultiprocessor(&per_cu, (const void*)mk_fwd, NWAVES * 64, LDS_BYTES) != hipSuccess || per_cu < 1) { fprintf(stderr, "kernel_launch: occupancy query reports %d workgroups per CU\n", per_cu); }
        (void)hipGetLastError();
        grid = cus;
        if (grid != 256) { fprintf(stderr, "kernel_launch: built for a 256-CU device (got %d CUs); nothing launched\n", cus); grid = -1; return; }
    }
    if (grid < 0) return;
    if (hipMemsetAsync((char*)d_ws + WS_CTL, 0, CTL_ZERO_BYTES, stream) != hipSuccess) return;
    Args a{};
    for (int i = 0; i < 34; ++i) a.in[i] = (const float*)d_in[i];
    a.out = (float*)d_out; a.ws = (unsigned char*)d_ws;
    int np = 0;
    for (int ph = 0; ph < N_PHASES; ++ph) {
        int kind = 0; if (ph > 0) { const int p = (ph - 1) % PH_PER_LAYER; kind = (p == 0 || p == 9) ? 1 : (p == 1 || p == 10) ? 2 : (p == 2 || p == 8 || p == 11) ? 3 : p == 3 ? 4 : p == 4 ? 5 : p == 5 ? 6 : p == 6 ? 7 : 8; }
        a.plist[np++] = (unsigned char)ph;
        if (PROBE_KIND >= 0 && PROBE_KIND != 3 && PROBE_KIND != 9 && kind == PROBE_KIND) a.plist[np++] = (unsigned char)(ph | 128);
    }
#if MK_SPLIT
    for (int it = 0; it < np; ++it) { a.ph_lo = it; a.ph_hi = it + 1; hipLaunchKernelGGL(mk_fwd, dim3(grid), dim3(NWAVES * 64), LDS_BYTES, stream, a); }
#else
    a.ph_lo = 0; a.ph_hi = np;
    hipLaunchKernelGGL(mk_fwd, dim3(grid), dim3(NWAVES * 64), LDS_BYTES, stream, a);
#endif
}
```
